# Optimizing an MI355X kernel written in HIP

```python
import math
import jax
import jax.numpy as jnp
from jax import lax
import numpy as np

D_MODEL = 1024
BATCH = 4
SEQ = 4096
DEPTH = 2

N_EVEN = (DEPTH + 1) // 2
N_ODD = DEPTH // 2
EPS = 1e-6
ROPE_THETA = 10000.0
Q_BLOCK = 128

MLA_HEADS = 8
MLA_Q_LORA = 384
MLA_KV_LORA = 256
MLA_NOPE = 64
MLA_ROPE = 32
MLA_V = 64
DIFF_HEADS = 4
DIFF_HD = 64
DIFF_V = 2 * DIFF_HD
A_IN = MLA_Q_LORA + MLA_KV_LORA + MLA_ROPE + 2 * DIFF_HEADS * 2 * DIFF_HD + DIFF_HEADS * DIFF_V
A_MIX = MLA_HEADS * MLA_V + DIFF_HEADS * DIFF_V

SSM_HEADS = 8
SSM_HEADDIM = 64
SSM_INNER = SSM_HEADS * SSM_HEADDIM
SSM_GROUPS = 2
SSM_STATE = 128
SSM_CONV = 4
SSM_CHUNK = 128
SSM_CONV_DIM = SSM_INNER + 2 * SSM_GROUPS * SSM_STATE
HG_HEADS = 4
HG_EXPAND = 128
HG_VDIM = 128
HG_KDIM_TOTAL = HG_HEADS * HG_EXPAND
HG_WIDTH = HG_HEADS * HG_VDIM
HG_CHUNK = 64
S_IN = SSM_INNER + SSM_CONV_DIM + SSM_HEADS + 2 * HG_KDIM_TOTAL + 2 * HG_WIDTH
S_MIX = SSM_INNER + HG_WIDTH

D_FF = -(-8 * D_MODEL // (3 * 256)) * 256

kernel_name = 'hybrid_mla_diffattn_ssd_hgrn2_block'

F32 = jnp.float32


def rms_norm(x, w):
    xf = x.astype(F32)
    y = xf * lax.rsqrt(jnp.mean(xf * xf, axis=-1, keepdims=True) + EPS)
    return (y * w.astype(F32)).astype(x.dtype)


def split_cols(y, sizes):
    offsets = [int(v) for v in np.cumsum(sizes)[:-1]]
    return jnp.split(y, offsets, axis=-1)


def rope_tables(seq_len, dim):
    inv_freq = 1.0 / (ROPE_THETA ** (jnp.arange(0, dim, 2, dtype=F32) / dim))
    ang = jnp.arange(seq_len, dtype=F32)[:, None] * inv_freq[None, :]
    ang = jnp.concatenate([ang, ang], axis=-1)
    return jnp.cos(ang), jnp.sin(ang)


def apply_rope(x, cos, sin):
    half = x.shape[-1] // 2
    x1, x2 = x[..., :half], x[..., half:]
    rot = jnp.concatenate([-x2, x1], axis=-1)
    return (x.astype(F32) * cos + rot.astype(F32) * sin).astype(x.dtype)


def causal_attention(q, k, v, scale):
    bsz, nh, s_len, dk = q.shape
    dv = v.shape[-1]
    nb = s_len // Q_BLOCK
    qb = q.reshape(bsz, nh, nb, Q_BLOCK, dk).transpose(2, 0, 1, 3, 4)
    kpos = jnp.arange(s_len)

    def one_block(args):
        qi, bi = args
        s = jnp.einsum('bhqd,bhkd->bhqk', qi, k, preferred_element_type=F32) * scale
        qpos = bi * Q_BLOCK + jnp.arange(Q_BLOCK)
        s = jnp.where(kpos[None, :] <= qpos[:, None], s, -jnp.inf)
        p = jax.nn.softmax(s, axis=-1)
        return jnp.einsum('bhqk,bhkd->bhqd', p.astype(v.dtype), v)

    out = lax.map(one_block, (qb, jnp.arange(nb)))
    return out.transpose(1, 2, 0, 3, 4).reshape(bsz, nh, s_len, dv)


def attention_mixer(h, w_in, q_norm, w_uq, kv_norm, w_ukv, lq1, lk1, lq2, lk2, subln, w_out, lambda_init):
    bsz, s_len, _ = h.shape
    proj = h @ w_in
    c_q, c_kv, k_rope, dq, dk, dv = split_cols(
        proj, [MLA_Q_LORA, MLA_KV_LORA, MLA_ROPE, DIFF_HEADS * 2 * DIFF_HD, DIFF_HEADS * 2 * DIFF_HD, DIFF_HEADS * DIFF_V])
    q = (rms_norm(c_q, q_norm) @ w_uq).reshape(bsz, s_len, MLA_HEADS, MLA_NOPE + MLA_ROPE).transpose(0, 2, 1, 3)
    q_nope, q_pe = q[..., :MLA_NOPE], q[..., MLA_NOPE:]
    kv = (rms_norm(c_kv, kv_norm) @ w_ukv).reshape(bsz, s_len, MLA_HEADS, MLA_NOPE + MLA_V).transpose(0, 2, 1, 3)
    k_nope, v_mla = kv[..., :MLA_NOPE], kv[..., MLA_NOPE:]
    cos_r, sin_r = rope_tables(s_len, MLA_ROPE)
    q_pe = apply_rope(q_pe, cos_r, sin_r)
    k_pe = apply_rope(k_rope[:, None], cos_r, sin_r)
    q_mla = jnp.concatenate([q_nope, q_pe], axis=-1)
    k_mla = jnp.concatenate([k_nope, jnp.broadcast_to(k_pe, (bsz, MLA_HEADS, s_len, MLA_ROPE))], axis=-1)
    o_mla = causal_attention(q_mla, k_mla, v_mla, (MLA_NOPE + MLA_ROPE) ** -0.5)
    o_mla = o_mla.transpose(0, 2, 1, 3).reshape(bsz, s_len, MLA_HEADS * MLA_V)
    cos_d, sin_d = rope_tables(s_len, DIFF_HD)
    dq = apply_rope(dq.reshape(bsz, s_len, DIFF_HEADS, 2, DIFF_HD).transpose(0, 3, 2, 1, 4), cos_d, sin_d)
    dk = apply_rope(dk.reshape(bsz, s_len, DIFF_HEADS, 2, DIFF_HD).transpose(0, 3, 2, 1, 4), cos_d, sin_d)
    dv = dv.reshape(bsz, s_len, DIFF_HEADS, DIFF_V).transpose(0, 2, 1, 3)
    v2 = jnp.broadcast_to(dv[:, None], (bsz, 2, DIFF_HEADS, s_len, DIFF_V)).reshape(bsz, 2 * DIFF_HEADS, s_len, DIFF_V)
    o2 = causal_attention(dq.reshape(bsz, 2 * DIFF_HEADS, s_len, DIFF_HD),
                          dk.reshape(bsz, 2 * DIFF_HEADS, s_len, DIFF_HD), v2, DIFF_HD ** -0.5)
    o2 = o2.reshape(bsz, 2, DIFF_HEADS, s_len, DIFF_V)
    lam = (jnp.exp(jnp.sum(lq1.astype(F32) * lk1.astype(F32))) - jnp.exp(jnp.sum(lq2.astype(F32) * lk2.astype(F32)))
           + lambda_init).astype(o2.dtype)
    o_diff = o2[:, 0] - lam * o2[:, 1]
    o_diff = rms_norm(o_diff, subln) * (1.0 - lambda_init)
    o_diff = o_diff.transpose(0, 2, 1, 3).reshape(bsz, s_len, DIFF_HEADS * DIFF_V)
    return jnp.concatenate([o_mla, o_diff], axis=-1) @ w_out


def causal_depthwise_conv(x, w, b):
    ch = x.shape[-1]
    y = lax.conv_general_dilated(x, w[:, None, :].astype(x.dtype), window_strides=(1,),
                                 padding=[(SSM_CONV - 1, 0)], dimension_numbers=('NWC', 'WIO', 'NWC'),
                                 feature_group_count=ch)
    return y + b


def ssd_chunked(xs, dt, a_head, b_in, c_in):
    bsz, s_len, _ = xs.shape
    nc, L = s_len // SSM_CHUNK, SSM_CHUNK
    G, R, P, N = SSM_GROUPS, SSM_HEADS // SSM_GROUPS, SSM_HEADDIM, SSM_STATE
    dtc = dt.reshape(bsz, nc, L, G, R)
    xh = xs.astype(F32).reshape(bsz, nc, L, G, R, P) * dtc[..., None]
    a = (dtc * a_head.reshape(G, R)).transpose(0, 1, 3, 4, 2)
    a_cs = jnp.cumsum(a, axis=-1)
    causal = jnp.tril(jnp.ones((L, L), dtype=bool))
    seg = jnp.exp(jnp.where(causal, a_cs[..., :, None] - a_cs[..., None, :], -jnp.inf))
    bc = b_in.astype(F32).reshape(bsz, nc, L, G, N)
    cc = c_in.astype(F32).reshape(bsz, nc, L, G, N)
    cb = jnp.einsum('bclgn,bcsgn->bcgls', cc, bc)
    y_diag = jnp.einsum('bcgls,bcgrls,bcsgrp->bclgrp', cb, seg, xh)
    decay_states = jnp.exp(a_cs[..., -1:] - a_cs)
    states = jnp.einsum('bclgn,bcgrl,bclgrp->bcgrpn', bc, decay_states, xh)
    chunk_decay = jnp.exp(a_cs[..., -1])

    def step(h_prev, inp):
        st, dec = inp
        return dec[..., None, None] * h_prev + st, h_prev

    h0 = jnp.zeros((bsz, G, R, P, N), F32)
    _, prev = lax.scan(step, h0, (states.transpose(1, 0, 2, 3, 4, 5), chunk_decay.transpose(1, 0, 2, 3)))
    prev = prev.transpose(1, 0, 2, 3, 4, 5)
    y_off = jnp.einsum('bclgn,bcgrpn,bcgrl->bclgrp', cc, prev, jnp.exp(a_cs))
    return (y_diag + y_off).reshape(bsz, s_len, SSM_HEADS, P)


def hgrn2_chunked(q, k, v, log_f):
    bsz, s_len, nh, kd = q.shape
    vd = v.shape[-1]
    nc, L = s_len // HG_CHUNK, HG_CHUNK

    def chunks(t):
        return t.astype(F32).reshape(bsz, nc, L, nh, t.shape[-1]).transpose(1, 0, 3, 2, 4)

    causal = jnp.tril(jnp.ones((L, L), dtype=bool))[None, None, :, :, None]

    def step(state, inp):
        qc, kc, vc, gc = inp
        g_cum = jnp.cumsum(gc, axis=2)
        g_last = g_cum[:, :, -1:, :]
        o_inter = jnp.einsum('bhlk,bhkv->bhlv', qc * jnp.exp(g_cum), state)
        decay = jnp.exp(jnp.where(causal, g_cum[:, :, :, None, :] - g_cum[:, :, None, :, :], -jnp.inf))
        scores = jnp.einsum('bhlk,bhlsk,bhsk->bhls', qc, decay, kc)
        o = o_inter + jnp.einsum('bhls,bhsv->bhlv', scores, vc)
        state = (jnp.exp(g_last[:, :, 0, :])[..., None] * state
                 + jnp.einsum('bhsk,bhsv->bhkv', kc * jnp.exp(g_last - g_cum), vc))
        return state, o

    s0 = jnp.zeros((bsz, nh, kd, vd), F32)
    _, o = lax.scan(step, s0, (chunks(q), chunks(k), chunks(v), chunks(log_f)))
    return o.transpose(1, 0, 3, 2, 4).reshape(bsz, s_len, nh, vd)


def recurrent_mixer(h, w_in, conv_w, conv_b, dt_bias, a_log, d_skip, ssm_norm, g_norm, lb, w_out):
    bsz, s_len, _ = h.shape
    proj = h @ w_in
    z, xbc, dt, hq, hf, hi, hg = split_cols(
        proj, [SSM_INNER, SSM_CONV_DIM, SSM_HEADS, HG_KDIM_TOTAL, HG_KDIM_TOTAL, HG_WIDTH, HG_WIDTH])
    xbc = jax.nn.silu(causal_depthwise_conv(xbc, conv_w, conv_b))
    xs, b_in, c_in = split_cols(xbc, [SSM_INNER, SSM_GROUPS * SSM_STATE, SSM_GROUPS * SSM_STATE])
    dt = jax.nn.softplus(dt.astype(F32) + dt_bias.astype(F32))
    a_head = -jnp.exp(a_log.astype(F32))
    y = ssd_chunked(xs, dt, a_head, b_in, c_in)
    y = y + d_skip.astype(F32)[:, None] * xs.astype(F32).reshape(bsz, s_len, SSM_HEADS, SSM_HEADDIM)
    y = y.astype(h.dtype).reshape(bsz, s_len, SSM_INNER) * jax.nn.silu(z)
    gsz = SSM_INNER // SSM_GROUPS
    y = rms_norm(y.reshape(bsz, s_len, SSM_GROUPS, gsz), ssm_norm.reshape(SSM_GROUPS, gsz)).reshape(bsz, s_len, SSM_INNER)
    lb = lb.astype(F32)
    xf = hf.astype(F32)
    log_f = jnp.logaddexp(jnp.log(lb), jnp.log1p(-lb) + jax.nn.log_sigmoid(xf))
    k_in = (1.0 - lb) * jax.nn.sigmoid(-xf)
    q = jax.nn.silu(hq).reshape(bsz, s_len, HG_HEADS, HG_EXPAND)
    o = hgrn2_chunked(q, k_in.reshape(bsz, s_len, HG_HEADS, HG_EXPAND), hi.reshape(bsz, s_len, HG_HEADS, HG_VDIM),
                      log_f.reshape(bsz, s_len, HG_HEADS, HG_EXPAND)).astype(h.dtype)
    o = rms_norm(o, g_norm) * jax.nn.silu(hg).reshape(bsz, s_len, HG_HEADS, HG_VDIM)
    o = o.reshape(bsz, s_len, HG_WIDTH)
    return jnp.concatenate([y, o], axis=-1) @ w_out


def swiglu(h, w_gate, w_up, w_down):
    return (jax.nn.silu(h @ w_gate) * (h @ w_up)) @ w_down


def setup_inputs(seed: int = 0) -> dict:
    key = jax.random.key(seed)
    ks = jax.random.split(key, 32)

    def nrm(k, shape, fan_in):
        return jax.random.normal(k, shape, F32) * (fan_in ** -0.5)

    def gain(k, shape):
        return 1.0 + 0.05 * jax.random.normal(k, shape, F32)

    dt0 = jnp.exp(jax.random.uniform(ks[20], (N_ODD, SSM_HEADS), F32, math.log(1e-3), math.log(1e-1)))
    return {
        'x': jax.random.normal(ks[0], (BATCH, SEQ, D_MODEL), F32),
        'norm_mix': gain(ks[1], (DEPTH, D_MODEL)),
        'norm_ffn': gain(ks[2], (DEPTH, D_MODEL)),
        'norm_final': gain(ks[3], (D_MODEL,)),
        'a_w_in': nrm(ks[4], (N_EVEN, D_MODEL, A_IN), D_MODEL),
        'a_q_norm': gain(ks[5], (N_EVEN, MLA_Q_LORA)),
        'a_w_uq': nrm(ks[6], (N_EVEN, MLA_Q_LORA, MLA_HEADS * (MLA_NOPE + MLA_ROPE)), MLA_Q_LORA),
        'a_kv_norm': gain(ks[7], (N_EVEN, MLA_KV_LORA)),
        'a_w_ukv': nrm(ks[8], (N_EVEN, MLA_KV_LORA, MLA_HEADS * (MLA_NOPE + MLA_V)), MLA_KV_LORA),
        'a_lq1': 0.1 * jax.random.normal(ks[9], (N_EVEN, DIFF_HD), F32),
        'a_lk1': 0.1 * jax.random.normal(ks[10], (N_EVEN, DIFF_HD), F32),
        'a_lq2': 0.1 * jax.random.normal(ks[11], (N_EVEN, DIFF_HD), F32),
        'a_lk2': 0.1 * jax.random.normal(ks[12], (N_EVEN, DIFF_HD), F32),
        'a_subln': gain(ks[13], (N_EVEN, DIFF_V)),
        'a_w_out': nrm(ks[14], (N_EVEN, A_MIX, D_MODEL), A_MIX),
        's_w_in': nrm(ks[15], (N_ODD, D_MODEL, S_IN), D_MODEL),
        's_conv_w': nrm(ks[16], (N_ODD, SSM_CONV, SSM_CONV_DIM), SSM_CONV),
        's_conv_b': 0.02 * jax.random.normal(ks[17], (N_ODD, SSM_CONV_DIM), F32),
        's_dt_bias': dt0 + jnp.log(-jnp.expm1(-dt0)),
        's_a_log': jnp.log(jax.random.uniform(ks[18], (N_ODD, SSM_HEADS), F32, 1.0, 16.0)),
        's_d': gain(ks[19], (N_ODD, SSM_HEADS)),
        's_norm': gain(ks[21], (N_ODD, SSM_INNER)),
        'h_g_norm': gain(ks[22], (N_ODD, HG_VDIM)),
        'h_lower_bound': 0.1 * jax.random.normal(ks[23], (DEPTH, HG_KDIM_TOTAL), F32),
        's_w_out': nrm(ks[24], (N_ODD, S_MIX, D_MODEL), S_MIX),
        'ffn_gate': nrm(ks[25], (DEPTH, D_MODEL, D_FF), D_MODEL),
        'ffn_up': nrm(ks[26], (DEPTH, D_MODEL, D_FF), D_MODEL),
        'ffn_down': nrm(ks[27], (DEPTH, D_FF, D_MODEL), D_FF),
    }


def reference(x, norm_mix, norm_ffn, norm_final, a_w_in, a_q_norm, a_w_uq, a_kv_norm, a_w_ukv,
              a_lq1, a_lk1, a_lq2, a_lk2, a_subln, a_w_out, s_w_in, s_conv_w, s_conv_b, s_dt_bias,
              s_a_log, s_d, s_norm, h_g_norm, h_lower_bound, s_w_out, ffn_gate, ffn_up, ffn_down):
    p_lb = jax.nn.softmax(h_lower_bound.astype(F32), axis=0)
    lb_all = jnp.cumsum(p_lb, axis=0) - p_lb[0:1]
    for l in range(DEPTH):
        hn = rms_norm(x, norm_mix[l])
        i = l // 2
        if l % 2 == 0:
            lambda_init = 0.8 - 0.6 * math.exp(-0.3 * l)
            m = attention_mixer(hn, a_w_in[i], a_q_norm[i], a_w_uq[i], a_kv_norm[i], a_w_ukv[i],
                                a_lq1[i], a_lk1[i], a_lq2[i], a_lk2[i], a_subln[i], a_w_out[i], lambda_init)
        else:
            m = recurrent_mixer(hn, s_w_in[i], s_conv_w[i], s_conv_b[i], s_dt_bias[i], s_a_log[i], s_d[i],
                                s_norm[i], h_g_norm[i], lb_all[l], s_w_out[i])
        x = x + m
        x = x + swiglu(rms_norm(x, norm_ffn[l]), ffn_gate[l], ffn_up[l], ffn_down[l])
    return rms_norm(x, norm_final)
```

```cpp
#include <hip/hip_runtime.h>
#include <hip/hip_cooperative_groups.h>
#include <cstdio>
#include <cstdint>
namespace cg = cooperative_groups;

#define DI __device__ __forceinline__
typedef unsigned short u16;
typedef short bf16x8 __attribute__((ext_vector_type(8)));
typedef float f32x16 __attribute__((ext_vector_type(16)));
typedef float f32x4 __attribute__((ext_vector_type(4)));
typedef float f32x2 __attribute__((ext_vector_type(2)));
typedef unsigned u32x4 __attribute__((ext_vector_type(4)));
typedef unsigned u32x2 __attribute__((ext_vector_type(2)));
typedef __bf16 bf2_t __attribute__((ext_vector_type(2)));

constexpr int T_ = 16384, S_ = 4096, NBATCH = 4;
constexpr int NTHR = 512;
#define GVAR 0
constexpr float EPS = 1e-6f;
constexpr float LOG2E = 1.4426950408889634f;

constexpr size_t OFF_CTRL = 0;
constexpr size_t OFF_BAR = 4096;
constexpr size_t OFF_SSQ = 32768;
constexpr size_t OFF_ROPED = OFF_SSQ + 8 * 65536;
constexpr size_t OFF_ROPEM = OFF_ROPED + (size_t)S_ * 32 * 8;
constexpr size_t OFF_WA = 2u << 20;
constexpr size_t W_IN0 = OFF_WA;
constexpr size_t W_UQ = W_IN0 + 2304u * 1024 * 2;
constexpr size_t W_UKV = W_UQ + 768u * 384 * 2;
constexpr size_t W_OUT0 = W_UKV + 1024u * 256 * 2;
constexpr size_t W_GU0 = W_OUT0 + 1024u * 1024 * 2;
constexpr size_t W_D0 = W_GU0 + 5632u * 1024 * 2;
constexpr size_t OFF_WA_END = W_D0 + 1024u * 2816 * 2;
constexpr size_t A_BTRAW = OFF_WA;
constexpr size_t A_SST = A_BTRAW + (size_t)NBATCH * 256 * S_ * 2;
static_assert(A_SST + (size_t)NBATCH * 32 * 8 * 64 * 128 * 2 <= OFF_WA_END, "alias");
constexpr size_t W_IN1 = OFF_WA_END;
constexpr size_t W_OUT1 = W_IN1 + 3840u * 1024 * 2;
constexpr size_t OFF_XB = W_OUT1 + 1024u * 1024 * 2;
constexpr size_t OFF_R = OFF_XB + (size_t)T_ * 1024 * 2;
constexpr size_t R_CQ = OFF_R;
constexpr size_t R_CKV = R_CQ + (size_t)T_ * 384 * 2;
constexpr size_t R_KR = R_CKV + (size_t)T_ * 256 * 2;
constexpr size_t R_DQ = R_KR + (size_t)T_ * 32 * 2;
constexpr size_t R_DK = R_DQ + (size_t)T_ * 512 * 2;
constexpr size_t R_DVT = R_DK + (size_t)T_ * 512 * 2;
constexpr size_t R_QM = R_DVT + (size_t)T_ * 512 * 2;
constexpr size_t R_KN = R_QM + (size_t)T_ * 768 * 2;
constexpr size_t R_VMT = R_KN + (size_t)T_ * 512 * 2;
constexpr size_t R_MIX0 = R_VMT + (size_t)T_ * 512 * 2;
constexpr size_t R_H = OFF_R;
constexpr size_t R_ZS = OFF_R;
constexpr size_t R_XTRAW = R_ZS + (size_t)T_ * 512 * 2;
constexpr size_t R_BCRAW = R_XTRAW + (size_t)T_ * 512 * 2;
constexpr size_t R_HVT = R_BCRAW + (size_t)T_ * 512 * 2;
constexpr size_t R_HG = R_HVT + (size_t)T_ * 512 * 2;
constexpr size_t R_DT = R_HG + (size_t)T_ * 512 * 2;
constexpr size_t R_LFT = R_DT + (size_t)T_ * 8 * 4;
constexpr size_t R_MIX1 = R_LFT;
constexpr size_t R_HQT = R_LFT + (size_t)T_ * 512 * 4;
constexpr size_t R_HKT = R_HQT + (size_t)T_ * 512 * 2;
constexpr size_t W_GU1 = R_HQT;
constexpr size_t W_D1 = W_GU1 + 5632u * 1024 * 2;
static_assert(W_D1 + 1024u * 2816 * 2 <= R_HKT + (size_t)T_ * 512 * 2, "alias");
static_assert(W_GU1 >= R_H + (size_t)T_ * 2816 * 2, "alias H");
constexpr size_t R_HS = R_HKT + (size_t)T_ * 512 * 2;
constexpr size_t R_SDEC = R_HS + (size_t)NBATCH * 4 * 64 * 128 * 128 * 2;
constexpr size_t R_HDEC = R_SDEC + 4096;
constexpr size_t WS_END = R_HDEC + (size_t)NBATCH * 4 * 64 * 128 * 4;
static_assert(R_MIX0 + (size_t)T_ * 1024 * 2 <= WS_END, "size");
constexpr size_t SSQP_Q = WS_END;
constexpr size_t SSQP_KV = SSQP_Q + (size_t)T_ * 8 * 4;
constexpr size_t SSQP_R = SSQP_KV + (size_t)T_ * 4 * 4;
constexpr size_t WS_END2 = SSQP_R + 4 * (size_t)T_ * 16 * 4;
static_assert(WS_END2 <= 268435456u, "workspace");
static_assert(WS_END <= 268435456u, "workspace");

struct Params {
    const float* in[28];
    float* out;
    unsigned char* ws;
};

DI unsigned pk2(float lo, float hi) { bf2_t v; v.x = (__bf16)lo; v.y = (__bf16)hi; return __builtin_bit_cast(unsigned, v); }
DI u16 f2bf(float x) { __bf16 b = (__bf16)x; return __builtin_bit_cast(u16, b); }
DI float bflo(unsigned u) { return __uint_as_float(u << 16); }
DI float bfhi(unsigned u) { return __uint_as_float(u & 0xffff0000u); }
DI float bf2f(u16 v) { return __uint_as_float(((unsigned)v) << 16); }
DI float silu_f(float x) { return x * __builtin_amdgcn_rcpf(1.f + __expf(-x)); }
DI float xor32(float v) {
    const auto r = __builtin_amdgcn_permlane32_swap(__float_as_uint(v), __float_as_uint(v), false, false);
    return __uint_as_float((threadIdx.x & 32) ? r[0] : r[1]);
}
#define MFMA32(a, b, c) __builtin_amdgcn_mfma_f32_32x32x16_bf16((a), (b), (c), 0, 0, 0)
DI int crow(int i, int h) { return (i & 3) + 8 * (i >> 2) + 4 * h; }
DI int perm32(int r) { return 16 * ((r >> 2) & 1) + 4 * (r >> 3) + (r & 3); }
DI f32x16 zero16() { f32x16 z; for (int i = 0; i < 16; ++i) z[i] = 0.f; return z; }
DI bf16x8 pack8(float a0, float a1, float a2, float a3, float a4, float a5, float a6, float a7) {
    u32x4 p; p.x = pk2(a0, a1); p.y = pk2(a2, a3); p.z = pk2(a4, a5); p.w = pk2(a6, a7); return __builtin_bit_cast(bf16x8, p);
}
DI void store_bf16x16(u16* dst, const f32x16& v) {
    u32x4 a, b;
    a.x = pk2(v[0], v[1]); a.y = pk2(v[2], v[3]); a.z = pk2(v[4], v[5]); a.w = pk2(v[6], v[7]);
    b.x = pk2(v[8], v[9]); b.y = pk2(v[10], v[11]); b.z = pk2(v[12], v[13]); b.w = pk2(v[14], v[15]);
    *(u32x4*)dst = a; *(u32x4*)(dst + 8) = b;
}
DI void store_T16(u16* base, const f32x16& v) {
#pragma unroll
    for (int i = 0; i < 16; ++i) base[(size_t)i * S_] = f2bf(v[i]);
}
DI float sumsq16(const f32x16& v) { float s = 0.f;
#pragma unroll
    for (int i = 0; i < 16; ++i) s += v[i] * v[i];
    return s; }


#define XB_TMO      128
#define XB_XCNT(j)  (256  + 64 * (j))
#define XB_XSUB(j)  (1280 + 64 * (j))
#define XB_XGEN(j)  (2304 + 64 * (j))
#define XB_TOP      3328
#define XB_TOPGEN   3392
#define XCD_BAR_WORDS 3456
#define XB_SPIN_CAP (1u << 18)
#define LAS __attribute__((address_space(3)))
DI unsigned xb_ld(unsigned* p) { return __hip_atomic_load(p, __ATOMIC_RELAXED, __HIP_MEMORY_SCOPE_AGENT); }
DI unsigned xb_add(unsigned* p, unsigned v) { return __hip_atomic_fetch_add(p, v, __ATOMIC_RELAXED, __HIP_MEMORY_SCOPE_AGENT); }
DI unsigned xb_xcc_id() { return (unsigned)__builtin_amdgcn_s_getreg((3 << 11) | 20) & 0xFu; }
#define XB_SPIN(cond, bar) do { unsigned _sp = 0; while (cond) { __builtin_amdgcn_s_sleep(1); \
    if ((++_sp & 255u) == 0u) { if (xb_ld(&(bar)[XB_TMO])) break; if (_sp > XB_SPIN_CAP) { atomicAdd(&(bar)[XB_TMO], 1u); break; } } } } while (0)
struct XcdBarrier { unsigned* bar; unsigned x; volatile LAS unsigned* st; };
DI XcdBarrier xcd_barrier_post(unsigned* bar, volatile LAS unsigned* st) {
    XcdBarrier b; b.bar = bar; b.x = xb_xcc_id(); b.st = st;
    if (threadIdx.x == 0) (void)xb_add(&bar[XB_XCNT(b.x)], 1u);
    return b;
}
DI void xcd_barrier_complete(unsigned* bar, unsigned x, unsigned& nloc, unsigned& nx) {
    const unsigned G = gridDim.x * gridDim.y * gridDim.z;
    unsigned sum, cnt, mine, sp = 0u;
    for (;;) {
        sum = 0u; cnt = 0u; mine = 0u;
#pragma unroll
        for (unsigned j = 0; j < 16; ++j) { const unsigned c = xb_ld(&bar[XB_XCNT(j)]); sum += c; cnt += (c > 0u) ? 1u : 0u; mine = (j == x) ? c : mine; }
        if (sum == G) break;
        __builtin_amdgcn_s_sleep(1);
        if ((++sp & 255u) == 0u) { if (xb_ld(&bar[XB_TMO])) break; if (sp > XB_SPIN_CAP) { atomicAdd(&bar[XB_TMO], 1u); break; } }
    }
    nloc = mine > 0u ? mine : 1u; nx = cnt > 0u ? cnt : 1u;
}
DI void xcd_barrier(const XcdBarrier& b) {
    asm volatile("s_waitcnt vmcnt(0)" ::: "memory");
    __syncthreads();
    if (threadIdx.x == 0) {
        unsigned* bar = b.bar;
        __builtin_amdgcn_s_waitcnt(0);
        unsigned nloc = b.st[0], nx = b.st[1];
        if (nloc == 0u) { xcd_barrier_complete(bar, b.x, nloc, nx); b.st[0] = nloc; b.st[1] = nx; }
        const unsigned old = xb_add(&bar[XB_XSUB(b.x)], 1u);
        const unsigned gen = old / nloc;
        if (old + 1u == (gen + 1u) * nloc) {
            __builtin_amdgcn_fence(__ATOMIC_RELEASE, "agent");
            asm volatile("s_waitcnt vmcnt(0)" ::: "memory");
            const unsigned og = xb_add(&bar[XB_TOP], 1u);
            const unsigned tg = og / nx;
            if (og + 1u == (tg + 1u) * nx) xb_add(&bar[XB_TOPGEN], 1u);
            else XB_SPIN(xb_ld(&bar[XB_TOPGEN]) == tg, bar);
            __builtin_amdgcn_fence(__ATOMIC_ACQUIRE, "agent");
            xb_add(&bar[XB_XGEN(b.x)], 1u);
            asm volatile("s_waitcnt vmcnt(0)" ::: "memory");
        } else {
            XB_SPIN(xb_ld(&bar[XB_XGEN(b.x)]) == gen, bar);
            __builtin_amdgcn_fence(__ATOMIC_ACQUIRE, "agent");
            asm volatile("s_waitcnt vmcnt(0)" ::: "memory");
        }
    }
    __syncthreads();
}

struct CJob { const float* src; const float* src2; const float* scale; u16* dst; int K, N, Npad, map; };
DI int srccol(int map, int n) {
    if (map == 0) return n;
    if (map == 1) { if (n < 640) return n; if (n < 2176) return n + 32; if (n < 2208) return n - 2176 + 640; return -1; }
    if (map == 2) { if (n < 1536) return n; if (n < 3584) return n + 8; if (n < 3592) return n - 3584 + 1536; return -1; }
    { const int j = n >> 6, w = n & 63; return (w < 32) ? (32 * j + w) : (32 * j + (w - 32) + (1 << 24)); }
}
DI CJob get_job(const Params& p, int id) {
    CJob j; j.src2 = nullptr; j.scale = nullptr; j.map = 0;
    unsigned char* ws = p.ws;
    switch (id) {
    case 0: j.src = p.in[4]; j.scale = p.in[1]; j.dst = (u16*)(ws + W_IN0); j.K = 1024; j.N = 2208; j.Npad = 2304; j.map = 1; break;
    case 1: j.src = p.in[6]; j.scale = p.in[5]; j.dst = (u16*)(ws + W_UQ); j.K = 384; j.N = 768; j.Npad = 768; break;
    case 2: j.src = p.in[8]; j.scale = p.in[7]; j.dst = (u16*)(ws + W_UKV); j.K = 256; j.N = 1024; j.Npad = 1024; break;
    case 3: j.src = p.in[14]; j.dst = (u16*)(ws + W_OUT0); j.K = 1024; j.N = 1024; j.Npad = 1024; break;
    case 4: j.src = p.in[25]; j.src2 = p.in[26]; j.scale = p.in[2]; j.dst = (u16*)(ws + W_GU0); j.K = 1024; j.N = 2816; j.Npad = 5632; j.map = 3; break;
    case 5: j.src = p.in[27]; j.dst = (u16*)(ws + W_D0); j.K = 2816; j.N = 1024; j.Npad = 1024; break;
    case 6: j.src = p.in[15]; j.scale = p.in[1] + 1024; j.dst = (u16*)(ws + W_IN1); j.K = 1024; j.N = 3592; j.Npad = 3840; j.map = 2; break;
    case 7: j.src = p.in[24]; j.dst = (u16*)(ws + W_OUT1); j.K = 1024; j.N = 1024; j.Npad = 1024; break;
    case 8: j.src = p.in[25] + (size_t)1024 * 2816; j.src2 = p.in[26] + (size_t)1024 * 2816; j.scale = p.in[2] + 1024; j.dst = (u16*)(ws + W_GU1); j.K = 1024; j.N = 2816; j.Npad = 5632; j.map = 3; break;
    default: j.src = p.in[27] + (size_t)2816 * 1024; j.dst = (u16*)(ws + W_D1); j.K = 2816; j.N = 1024; j.Npad = 1024; break;
    }
    return j;
}
DI int job_tiles(int id) {
    switch (id) {
    case 0: return 9 * 16;  case 1: return 3 * 6;   case 2: return 4 * 4;   case 3: return 4 * 16;  case 4: return 22 * 16;
    case 5: return 4 * 44;  case 6: return 15 * 16; case 7: return 4 * 16;  case 8: return 22 * 16; default: return 4 * 44;
    }
}
DI bool job_locate(int t, int j0, int j1, int& id, int& lt) {
    for (int j = j0; j < j1; ++j) { const int n = job_tiles(j); if (t < n) { id = j; lt = t; return true; } t -= n; }
    return false;
}
DI void convert_jobs(const Params& p, int j0, int j1, char* lds, const int dry) {
    float* tile = (float*)lds;
    const int tid = threadIdx.x;
    const int n4 = tid & 63, kk_r = tid >> 6;
    f32x4 cur[8];
    auto load_tile = [&](const CJob& j, int lt) {
        const int ntn = j.Npad / 256;
        const int tn = lt % ntn, tk = lt / ntn;
        int sc = srccol(j.map, tn * 256 + 4 * n4);
        const float* s = j.src;
        if (sc >= (1 << 24)) { sc -= (1 << 24); s = j.src2; }
#pragma unroll
        for (int i = 0; i < 8; ++i) {
            const int k = tk * 64 + kk_r + 8 * i;
            f32x4 v; v.x = v.y = v.z = v.w = 0.f;
            if (sc >= 0) { v = *(const f32x4*)(s + (size_t)k * j.N + sc); if (j.scale) { const float sk = j.scale[k]; v.x *= sk; v.y *= sk; v.z *= sk; v.w *= sk; } }
            cur[i] = v;
        }
    };
    int t = blockIdx.x, id, lt;
    bool have = job_locate(t, j0, j1, id, lt);
    if (have) load_tile(get_job(p, id), lt);
    while (have) {
        const CJob j = get_job(p, id);
        const int ntn = j.Npad / 256;
        const int n0 = (lt % ntn) * 256, k0 = (lt / ntn) * 64;
#pragma unroll
        for (int i = 0; i < 8; ++i) {
            float* d = tile + (kk_r + 8 * i) * 257 + 4 * n4;
            d[0] = cur[i].x; d[1] = cur[i].y; d[2] = cur[i].z; d[3] = cur[i].w;
        }
        __syncthreads();
        t += gridDim.x;
        have = job_locate(t, j0, j1, id, lt);
        if (have) load_tile(get_job(p, id), lt);
        {
            const int kp = tid & 31;
#pragma unroll 4
            for (int i = 0; i < 16; ++i) {
                const int nn = (tid >> 5) + 16 * i;
                const unsigned v = pk2(tile[(2 * kp) * 257 + nn], tile[(2 * kp + 1) * 257 + nn]);
                if (!dry) *(unsigned*)(j.dst + (size_t)(n0 + nn) * j.K + k0 + 2 * kp) = v;
            }
        }
        __syncthreads();
    }
}

DI void phase0(const Params& p, char* lds, const int dry) {
    const int tid = threadIdx.x;
    const int gtid = blockIdx.x * NTHR + tid, gsz = gridDim.x * NTHR;
    float* ssq = (float*)(p.ws + OFF_SSQ);
    unsigned* ctrl = (unsigned*)(p.ws + OFF_CTRL);
    if (gtid == 0) {
        float s1 = 0.f, s2 = 0.f;
        for (int i = 0; i < 64; ++i) { s1 += p.in[9][i] * p.in[10][i]; s2 += p.in[11][i] * p.in[12][i]; }
        if (!dry) ((float*)ctrl)[16] = expf(s1) - expf(s2) + 0.2f;
    }
    if (gtid < 512 && !dry) ((float*)ctrl)[64 + gtid] = 1.f / (1.f + expf(p.in[23][gtid] - p.in[23][512 + gtid]));
    f32x2* rd = (f32x2*)(p.ws + OFF_ROPED);
    for (int i = gtid; i < S_ * 32; i += gsz) {
        const int pos = i >> 5, d = i & 31;
        const float inv = 1.0f / powf(10000.0f, (float)(2 * d) / 64.0f);
        const float ang = (float)pos * inv;
        f32x2 cs; cs.x = cosf(ang); cs.y = sinf(ang); if (!dry) rd[i] = cs;
    }
    f32x2* rm = (f32x2*)(p.ws + OFF_ROPEM);
    for (int i = gtid; i < S_ * 16; i += gsz) {
        const int pos = i >> 4, d = i & 15;
        const float inv = 1.0f / powf(10000.0f, (float)(2 * d) / 32.0f);
        const float ang = (float)pos * inv;
        f32x2 cs; cs.x = cosf(ang); cs.y = sinf(ang); if (!dry) rm[i] = cs;
    }
    {
        const int lane = tid & 63, gw = gtid >> 6, nw = gsz >> 6;
        const float* x = p.in[0];
        u16* xb = (u16*)(p.ws + OFF_XB);
        for (int row0 = gw * 4; row0 < T_; row0 += nw * 4) {
            f32x4 v[4][4];
#pragma unroll
            for (int rr = 0; rr < 4; ++rr)
#pragma unroll
                for (int jj = 0; jj < 4; ++jj) v[rr][jj] = *(const f32x4*)(x + (size_t)(row0 + rr) * 1024 + jj * 256 + lane * 4);
#pragma unroll
            for (int rr = 0; rr < 4; ++rr) {
                float s = 0.f;
#pragma unroll
                for (int jj = 0; jj < 4; ++jj) {
                    const f32x4 q = v[rr][jj];
                    s += q.x * q.x + q.y * q.y + q.z * q.z + q.w * q.w;
                    u32x2 o; o.x = pk2(q.x, q.y); o.y = pk2(q.z, q.w);
                    if (!dry) *(u32x2*)(xb + (size_t)(row0 + rr) * 1024 + jj * 256 + lane * 4) = o;
                }
#pragma unroll
                for (int off = 32; off > 0; off >>= 1) s += __shfl_xor(s, off, 64);
                if (lane == 0 && !dry) ssq[row0 + rr] = s;
            }
        }
    }
    convert_jobs(p, 0, 8, lds, dry);
}

constexpr int LROW = 144;
constexpr int GEMM_LDS = 147456;

constexpr int DSTG = 32768;
#define RAW_BARRIER() do { asm volatile("s_waitcnt lgkmcnt(0)" ::: "memory"); __builtin_amdgcn_s_barrier(); } while (0)
DI void glds16(const char* g, char* l) { __builtin_amdgcn_global_load_lds((const unsigned*)g, (unsigned*)l, 16, 0, 0); }
template <int HALF, class Epi>
DI void gemm_tile(const u16* __restrict__ A, int lda, const u16* __restrict__ W, int ldw, int K, int m0, int n0, char* lds, Epi&& epi) {
    constexpr int MT = HALF ? 2 : 4;
    constexpr int NI = HALF ? 3 : 4;
    int tid = threadIdx.x;
    asm volatile("" : "+v"(tid));
    const int wave = tid >> 6, lane = tid & 63, r = lane & 31, h = lane >> 5;
    const int wm = HALF ? (wave >> 1) : (wave >> 2), wn = HALF ? (wave & 1) : (wave & 3);
    f32x16 acc[MT][2];
#pragma unroll
    for (int mt = 0; mt < MT; ++mt) { acc[mt][0] = zero16(); acc[mt][1] = zero16(); }
    const int drow = lane >> 2, dchunk = (lane & 3) ^ ((drow >> 2) & 3);
    const char* asrc = (const char*)(A + (size_t)(m0 + 32 * wave + drow) * lda) + dchunk * 16;
    const char* wsrc = (const char*)(W + (size_t)(n0 + (HALF ? 16 : 32) * wave + drow) * ldw) + dchunk * 16;
    const size_t a16 = (size_t)lda * 32, w16 = (size_t)ldw * 32;
    char* dbase = lds + wave * 2048;
    char* wbase = lds + 16384 + wave * (HALF ? 1024 : 2048);
    const int nk = K >> 5;
    RAW_BARRIER();
#define GEMM_ISSUE(kt_) do { const int so_ = ((kt_) & 3) * DSTG; const int ko_ = (kt_) * 64; \
        glds16(asrc + ko_, dbase + so_); glds16(asrc + a16 + ko_, dbase + so_ + 1024); glds16(wsrc + ko_, wbase + so_); if (!HALF) glds16(wsrc + w16 + ko_, wbase + so_ + 1024); } while (0)
#define GEMM_WAIT(n_) do { if ((n_) >= 2) { if (HALF) asm volatile("s_waitcnt vmcnt(6)" ::: "memory"); else asm volatile("s_waitcnt vmcnt(8)" ::: "memory"); } \
        else if ((n_) == 1) { if (HALF) asm volatile("s_waitcnt vmcnt(3)" ::: "memory"); else asm volatile("s_waitcnt vmcnt(4)" ::: "memory"); } \
        else asm volatile("s_waitcnt vmcnt(0)" ::: "memory"); } while (0)
    GEMM_ISSUE(0);
    if (nk > 1) GEMM_ISSUE(1);
    if (nk > 2) GEMM_ISSUE(2);
    const int a_rd = (wm * (HALF ? 64 : 128) + r) * 64, a_sw = (r >> 2) & 3;
    const int w_rd = 16384 + (wn * 64 + perm32(r)) * 64, w_sw = r >> 3;
    GEMM_WAIT(nk > 2 ? 2 : (nk > 1 ? 1 : 0));
    RAW_BARRIER();
    bf16x8 fa[MT], fw[2];
#pragma unroll
    for (int mt = 0; mt < MT; ++mt) fa[mt] = *(const bf16x8*)(lds + a_rd + mt * 2048 + ((h ^ a_sw) << 4));
    fw[0] = *(const bf16x8*)(lds + w_rd + ((h ^ w_sw) << 4));
    fw[1] = *(const bf16x8*)(lds + w_rd + 2048 + ((h ^ w_sw) << 4));
    for (int kt = 0; kt < nk; ++kt) {
        if (kt + 3 < nk) GEMM_ISSUE(kt + 3);
        const char* buf = lds + (kt & 3) * DSTG;
        bf16x8 ga[MT], gw[2];
#pragma unroll
        for (int mt = 0; mt < MT; ++mt) ga[mt] = *(const bf16x8*)(buf + a_rd + mt * 2048 + (((2 + h) ^ a_sw) << 4));
        gw[0] = *(const bf16x8*)(buf + w_rd + (((2 + h) ^ w_sw) << 4));
        gw[1] = *(const bf16x8*)(buf + w_rd + 2048 + (((2 + h) ^ w_sw) << 4));
#pragma unroll
        for (int mt = 0; mt < MT; ++mt) {
            acc[mt][0] = MFMA32(fw[0], fa[mt], acc[mt][0]);
            acc[mt][1] = MFMA32(fw[1], fa[mt], acc[mt][1]);
        }
        const int rem = nk - 1 - kt;
        if (rem >= 1) {
            GEMM_WAIT(rem >= 3 ? 2 : rem - 1);
            RAW_BARRIER();
            const char* nb = lds + ((kt + 1) & 3) * DSTG;
#pragma unroll
            for (int mt = 0; mt < MT; ++mt) fa[mt] = *(const bf16x8*)(nb + a_rd + mt * 2048 + ((h ^ a_sw) << 4));
            fw[0] = *(const bf16x8*)(nb + w_rd + ((h ^ w_sw) << 4));
            fw[1] = *(const bf16x8*)(nb + w_rd + 2048 + ((h ^ w_sw) << 4));
        }
#pragma unroll
        for (int mt = 0; mt < MT; ++mt) {
            acc[mt][0] = MFMA32(gw[0], ga[mt], acc[mt][0]);
            acc[mt][1] = MFMA32(gw[1], ga[mt], acc[mt][1]);
        }
    }
#undef GEMM_ISSUE
#undef GEMM_WAIT
    const int colbase = n0 + wn * 64;
#pragma unroll
    for (int mt = 0; mt < MT; ++mt) epi(m0 + wm * (HALF ? 64 : 128) + mt * 32 + r, colbase, acc[mt][0], acc[mt][1]);
}

DI bool tile_map(int round, int NT, int& mi, int& ni, int& half) {
    const int x = blockIdx.x & 7, l = blockIdx.x >> 3, nl = gridDim.x >> 3;
    const int q = l + nl * round;
    const int F = 8 * NT, full = (F / nl) * nl;
    int t;
    if (q < full) { t = q; half = -1; }
    else {
        const int qh = q - full;
        if (qh >= 2 * (F - full)) return false;
        t = full + (qh >> 1); half = qh & 1;
    }
    const int ng = t >> 5, idx = t & 31;
    mi = 8 * x + (idx & 7);
    ni = 4 * ng + (idx >> 3);
    return true;
}
#define GEMM_DISPATCH(A_, lda_, W_, ldw_, K_, mi_, ncol0_, half_, epi_) do { \
        if ((half_) < 0) gemm_tile<0>(A_, lda_, W_, ldw_, K_, (mi_) * 256, (ncol0_), lds, epi_); \
        else gemm_tile<1>(A_, lda_, W_, ldw_, K_, (mi_) * 256, (ncol0_) + 128 * (half_), lds, epi_); } while (0)

DI void scale16(f32x16& v, float s) {
#pragma unroll
    for (int i = 0; i < 16; ++i) v[i] *= s;
}
DI void rope32(f32x16& v, const f32x2* tab, int h) {
#pragma unroll
    for (int i = 0; i < 16; ++i) {
        const float o = xor32(v[i]);
        const f32x2 cs = tab[i];
        v[i] = (h == 0) ? (v[i] * cs.x - o * cs.y) : (v[i] * cs.x + o * cs.y);
    }
}
DI void rope64(f32x16& c0, f32x16& c1, const f32x2* tab, int h) {
#pragma unroll
    for (int i = 0; i < 16; ++i) {
        const f32x2 cs = tab[16 * h + i];
        const float x1 = c0[i], x2 = c1[i];
        c0[i] = x1 * cs.x - x2 * cs.y;
        c1[i] = x2 * cs.x + x1 * cs.y;
    }
}
DI void ssq_put(float* slot, float part, int h) {
    part += xor32(part);
    if (h == 0) *slot = part;
}
DI float ssq_get16(const float* row16) {
    const f32x4 a = *(const f32x4*)row16, b = *(const f32x4*)(row16 + 4), c = *(const f32x4*)(row16 + 8), d = *(const f32x4*)(row16 + 12);
    return ((a.x + a.y) + (a.z + a.w)) + ((b.x + b.y) + (b.z + b.w)) + (((c.x + c.y) + (c.z + c.w)) + ((d.x + d.y) + (d.z + d.w)));
}

DI void phase_inproj0(const Params& p, char* lds, const int dry) {
    unsigned char* ws = p.ws;
    const u16* A = (const u16*)(ws + OFF_XB);
    const u16* W = (const u16*)(ws + W_IN0);
    const float* ssq0 = (const float*)(ws + OFF_SSQ);
    float* ssq_q = (float*)(ws + SSQP_Q);
    float* ssq_kv = (float*)(ws + SSQP_KV);
    const f32x2* ropeD = (const f32x2*)(ws + OFF_ROPED);
    const f32x2* ropeM = (const f32x2*)(ws + OFF_ROPEM);
    const int h = (threadIdx.x & 63) >> 5;
    auto epi = [&](int row, int cb, f32x16& c0, f32x16& c1) {
        if (dry) return;
        const float rs = rsqrtf(ssq0[row] * (1.f / 1024.f) + EPS);
        scale16(c0, rs); scale16(c1, rs);
        const int pos = row & (S_ - 1), b = row >> 12;
        if (cb < 384) {
            u16* d = (u16*)(ws + R_CQ) + (size_t)row * 384 + cb + 16 * h;
            store_bf16x16(d, c0); store_bf16x16(d + 32, c1);
            ssq_put(ssq_q + (size_t)row * 8 + (cb >> 6), sumsq16(c0) + sumsq16(c1), h);
        } else if (cb < 640) {
            u16* d = (u16*)(ws + R_CKV) + (size_t)row * 256 + (cb - 384) + 16 * h;
            store_bf16x16(d, c0); store_bf16x16(d + 32, c1);
            ssq_put(ssq_kv + (size_t)row * 4 + ((cb - 384) >> 6), sumsq16(c0) + sumsq16(c1), h);
        } else if (cb < 1152) {
            rope64(c0, c1, ropeD + (size_t)pos * 32, h);
            scale16(c0, 0.125f * LOG2E); scale16(c1, 0.125f * LOG2E);
            u16* d = (u16*)(ws + R_DQ) + (size_t)row * 512 + (cb - 640) + 16 * h;
            store_bf16x16(d, c0); store_bf16x16(d + 32, c1);
        } else if (cb < 1664) {
            rope64(c0, c1, ropeD + (size_t)pos * 32, h);
            u16* d = (u16*)(ws + R_DK) + (size_t)row * 512 + (cb - 1152) + 16 * h;
            store_bf16x16(d, c0); store_bf16x16(d + 32, c1);
        } else if (cb < 2176) {
            u16* d = (u16*)(ws + R_DVT) + ((size_t)b * 512 + (cb - 1664) + 16 * h) * S_ + pos;
            store_T16(d, c0); store_T16(d + (size_t)32 * S_, c1);
        } else if (cb == 2176) {
            rope32(c0, ropeM + (size_t)pos * 16, h);
            store_bf16x16((u16*)(ws + R_KR) + (size_t)row * 32 + 16 * h, c0);
        }
    };
    constexpr int NT = 9;
    { int mi, ni, hf; for (int rd = 0; tile_map(rd, NT, mi, ni, hf); ++rd) GEMM_DISPATCH(A, 1024, W, 1024, 1024, mi, ni * 256, hf, epi); }
}

DI void phase_upproj0(const Params& p, char* lds, const int dry) {
    unsigned char* ws = p.ws;
    const float* ssq_q = (const float*)(ws + SSQP_Q);
    const float* ssq_kv = (const float*)(ws + SSQP_KV);
    const f32x2* ropeM = (const f32x2*)(ws + OFF_ROPEM);
    const int h = (threadIdx.x & 63) >> 5;
    auto epi_q = [&](int row, int cb, f32x16& c0, f32x16& c1) {
        if (dry) return;
        const f32x4 qa = *(const f32x4*)(ssq_q + (size_t)row * 8); const f32x2 qb = *(const f32x2*)(ssq_q + (size_t)row * 8 + 4);
        const float rs = rsqrtf((((qa.x + qa.y) + (qa.z + qa.w)) + (qb.x + qb.y)) * (1.f / 384.f) + EPS) * (0.10206207261596575f * LOG2E);
        scale16(c0, rs); scale16(c1, rs);
        const int pos = row & (S_ - 1);
        const int blk = cb >> 5;
        if (blk % 3 == 2) rope32(c0, ropeM + (size_t)pos * 16, h);
        if ((blk + 1) % 3 == 2) rope32(c1, ropeM + (size_t)pos * 16, h);
        u16* d = (u16*)(ws + R_QM) + (size_t)row * 768 + cb + 16 * h;
        store_bf16x16(d, c0); store_bf16x16(d + 32, c1);
    };
    auto epi_kv = [&](int row, int cb, f32x16& c0, f32x16& c1) {
        if (dry) return;
        const f32x4 ka = *(const f32x4*)(ssq_kv + (size_t)row * 4);
        const float rs = rsqrtf(((ka.x + ka.y) + (ka.z + ka.w)) * (1.f / 256.f) + EPS);
        scale16(c0, rs); scale16(c1, rs);
        const int pos = row & (S_ - 1), b = row >> 12;
        const int head = cb >> 7;
        if ((cb & 64) == 0) {
            u16* d = (u16*)(ws + R_KN) + (size_t)row * 512 + head * 64 + 16 * h;
            store_bf16x16(d, c0); store_bf16x16(d + 32, c1);
        } else {
            u16* d = (u16*)(ws + R_VMT) + ((size_t)b * 512 + head * 64 + 16 * h) * S_ + pos;
            store_T16(d, c0); store_T16(d + (size_t)32 * S_, c1);
        }
    };
    int mi, ni, hf;
    for (int rd = 0; tile_map(rd, 7, mi, ni, hf); ++rd) {
        if (ni < 3) GEMM_DISPATCH((const u16*)(ws + R_CQ), 384, (const u16*)(ws + W_UQ), 384, 384, mi, ni * 256, hf, epi_q);
        else GEMM_DISPATCH((const u16*)(ws + R_CKV), 256, (const u16*)(ws + W_UKV), 256, 256, mi, (ni - 3) * 256, hf, epi_kv);
    }
}

DI void phase_resid(const Params& p, char* lds, const u16* A, int K, const u16* W, float* ssq_out, const int dry) {
    unsigned char* ws = p.ws;
    const int h = (threadIdx.x & 63) >> 5;
    auto epi = [&](int row, int cb, f32x16& c0, f32x16& c1) {
        if (dry) return;
        u16* d = (u16*)(ws + OFF_XB) + (size_t)row * 1024 + cb + 16 * h;
        const u32x4 r0a = *(const u32x4*)d, r0b = *(const u32x4*)(d + 8), r1a = *(const u32x4*)(d + 32), r1b = *(const u32x4*)(d + 40);
        c0[0] += bflo(r0a.x); c0[1] += bfhi(r0a.x); c0[2] += bflo(r0a.y); c0[3] += bfhi(r0a.y); c0[4] += bflo(r0a.z); c0[5] += bfhi(r0a.z); c0[6] += bflo(r0a.w); c0[7] += bfhi(r0a.w);
        c0[8] += bflo(r0b.x); c0[9] += bfhi(r0b.x); c0[10] += bflo(r0b.y); c0[11] += bfhi(r0b.y); c0[12] += bflo(r0b.z); c0[13] += bfhi(r0b.z); c0[14] += bflo(r0b.w); c0[15] += bfhi(r0b.w);
        c1[0] += bflo(r1a.x); c1[1] += bfhi(r1a.x); c1[2] += bflo(r1a.y); c1[3] += bfhi(r1a.y); c1[4] += bflo(r1a.z); c1[5] += bfhi(r1a.z); c1[6] += bflo(r1a.w); c1[7] += bfhi(r1a.w);
        c1[8] += bflo(r1b.x); c1[9] += bfhi(r1b.x); c1[10] += bflo(r1b.y); c1[11] += bfhi(r1b.y); c1[12] += bflo(r1b.z); c1[13] += bfhi(r1b.z); c1[14] += bflo(r1b.w); c1[15] += bfhi(r1b.w);
        store_bf16x16(d, c0); store_bf16x16(d + 32, c1);
        ssq_put(ssq_out + (size_t)row * 16 + (cb >> 6), sumsq16(c0) + sumsq16(c1), h);
    };
    { int mi, ni, hf; for (int rd = 0; tile_map(rd, 4, mi, ni, hf); ++rd) GEMM_DISPATCH(A, K, W, K, K, mi, ni * 256, hf, epi); }
}

DI void phase_ffn_up(const Params& p, char* lds, const u16* W, const float* ssq, const int dry) {
    unsigned char* ws = p.ws;
    const int h = (threadIdx.x & 63) >> 5;
    auto epi = [&](int row, int cb, f32x16& c0, f32x16& c1) {
        if (dry) return;
        const float rs = rsqrtf(ssq_get16(ssq + (size_t)row * 16) * (1.f / 1024.f) + EPS);
        f32x16 hv;
#pragma unroll
        for (int i = 0; i < 16; ++i) { const float g = c0[i] * rs, u = c1[i] * rs; hv[i] = silu_f(g) * u; }
        store_bf16x16((u16*)(ws + R_H) + (size_t)row * 2816 + (cb >> 1) + 16 * h, hv);
    };
    constexpr int NT = 22;
    { int mi, ni, hf; for (int rd = 0; tile_map(rd, NT, mi, ni, hf); ++rd) GEMM_DISPATCH((const u16*)(ws + OFF_XB), 1024, W, 1024, 1024, mi, ni * 256, hf, epi); }
}

template <bool MLA>
DI void attn_pass(const u16* __restrict__ qbase, int qld, const u16* __restrict__ kbase, int kld, const u16* __restrict__ krbase,
                  const u16* __restrict__ vtbase, int q0, char* lds, f32x16 (&o)[MLA ? 2 : 4], float& linv) {
    constexpr int DKD = MLA ? 96 : 64, DVD = MLA ? 64 : 128, NKS = DKD / 16, NVT = DVD / 32, CPR = DKD / 8, NKC = (64 * CPR + NTHR - 1) / NTHR, NVC = DVD * 8 / NTHR;
    constexpr int KSTR = DKD * 2 + 16, BUF = 64 * KSTR + DVD * LROW;
    int tid = threadIdx.x;
    asm volatile("" : "+v"(tid));
    const int wave = tid >> 6, lane = tid & 63, r = lane & 31, h = lane >> 5;
    const int qw0 = q0 + 32 * wave;
    bf16x8 qf[NKS];
#pragma unroll
    for (int ks = 0; ks < NKS; ++ks) qf[ks] = *(const bf16x8*)(qbase + (size_t)(qw0 + r) * qld + ks * 16 + h * 8);
    float m = -INFINITY, l = 0.f;
#pragma unroll
    for (int vt = 0; vt < NVT; ++vt) o[vt] = zero16();
    const int ntiles = (q0 >> 6) + 4;
    u32x4 rk[NKC], rv[NVC];
#pragma unroll
    for (int i = 0; i < NKC; ++i) {
        const int c = tid + NTHR * i, row = c / CPR, cc = c % CPR;
        if (c < 64 * CPR) {
            if (MLA && cc >= 8) rk[i] = *(const u32x4*)(krbase + (size_t)row * 32 + (cc - 8) * 8);
            else rk[i] = *(const u32x4*)(kbase + (size_t)row * kld + cc * 8);
        }
    }
#pragma unroll
    for (int i = 0; i < NVC; ++i) { const int c = tid + NTHR * i, row = c >> 3, cc = c & 7; rv[i] = *(const u32x4*)(vtbase + (size_t)row * S_ + cc * 8); }
#pragma unroll
    for (int i = 0; i < NKC; ++i) { const int c = tid + NTHR * i, row = c / CPR, cc = c % CPR; if (c < 64 * CPR) *(u32x4*)(lds + row * KSTR + cc * 16) = rk[i]; }
#pragma unroll
    for (int i = 0; i < NVC; ++i) { const int c = tid + NTHR * i, row = c >> 3, cc = c & 7; char* d_ = lds + 64 * KSTR + row * LROW + (cc >> 1) * 32 + (cc & 1) * 8; u32x2 a_, b_; a_.x = rv[i].x; a_.y = rv[i].y; b_.x = rv[i].z; b_.y = rv[i].w; *(u32x2*)d_ = a_; *(u32x2*)(d_ + 16) = b_; }
    __syncthreads();
    for (int kt = 0; kt < ntiles; ++kt) {
        const char* buf = lds + (kt & 1) * BUF;
        if (kt + 1 < ntiles) {
            const int kb = (kt + 1) * 64;
#pragma unroll
            for (int i = 0; i < NKC; ++i) {
                const int c = tid + NTHR * i, row = c / CPR, cc = c % CPR;
                if (c < 64 * CPR) {
                    if (MLA && cc >= 8) rk[i] = *(const u32x4*)(krbase + (size_t)(kb + row) * 32 + (cc - 8) * 8);
                    else rk[i] = *(const u32x4*)(kbase + (size_t)(kb + row) * kld + cc * 8);
                }
            }
#pragma unroll
            for (int i = 0; i < NVC; ++i) { const int c = tid + NTHR * i, row = c >> 3, cc = c & 7; rv[i] = *(const u32x4*)(vtbase + (size_t)row * S_ + kb + cc * 8); }
        }
        __builtin_amdgcn_sched_barrier(0);
        if (64 * kt <= qw0 + 31) {
            f32x16 s0 = zero16(), s1 = zero16();
            {
                bf16x8 kf0[NKS], kf1[NKS];
#pragma unroll
                for (int ks = 0; ks < NKS; ++ks) {
                    kf0[ks] = *(const bf16x8*)(buf + r * KSTR + ks * 32 + h * 16);
                    kf1[ks] = *(const bf16x8*)(buf + (32 + r) * KSTR + ks * 32 + h * 16);
                }
                __builtin_amdgcn_sched_barrier(0);
                __builtin_amdgcn_s_setprio(1);
#pragma unroll
                for (int ks = 0; ks < NKS; ++ks) {
                    s0 = MFMA32(kf0[ks], qf[ks], s0);
                    s1 = MFMA32(kf1[ks], qf[ks], s1);
                }
                __builtin_amdgcn_s_setprio(0);
            }
            const char* vb = buf + 64 * KSTR + r * LROW + h * 16;
            u32x4 va[NVT][2];
#pragma unroll
            for (int vt = 0; vt < NVT; ++vt)
#pragma unroll
                for (int ms = 0; ms < 2; ++ms) {
                    va[vt][ms] = *(const u32x4*)(vb + vt * 32 * LROW + ms * 32);
                }
            u32x4 vc[NVT][2];
            if (MLA) {
#pragma unroll
                for (int vt = 0; vt < NVT; ++vt)
#pragma unroll
                    for (int ms = 2; ms < 4; ++ms) vc[vt][ms - 2] = *(const u32x4*)(vb + vt * 32 * LROW + ms * 32);
            }
            __builtin_amdgcn_sched_barrier(0);
            if (64 * kt + 63 > qw0) {
                const int q = qw0 + r;
#pragma unroll
                for (int i = 0; i < 16; ++i) {
                    const int key = 64 * kt + crow(i, h);
                    if (key > q) s0[i] = -INFINITY;
                    if (key + 32 > q) s1[i] = -INFINITY;
                }
            }
            float mx = s0[0];
#pragma unroll
            for (int i = 1; i < 16; ++i) mx = fmaxf(mx, s0[i]);
#pragma unroll
            for (int i = 0; i < 16; ++i) mx = fmaxf(mx, s1[i]);
            if (__builtin_amdgcn_ballot_w64(mx - m > 8.0f) != 0ull) {
                mx = fmaxf(mx, xor32(mx));
                const float mn = fmaxf(m, mx);
                const float alpha = __builtin_amdgcn_exp2f(m - mn);
                m = mn;
                l *= alpha;
#pragma unroll
                for (int vt = 0; vt < NVT; ++vt) scale16(o[vt], alpha);
            }
            const float mn = m;
            float ps = 0.f;
#pragma unroll
            for (int i = 0; i < 8; ++i) {
                f32x2 nm; nm.x = -mn; nm.y = -mn;
                f32x2 a; a.x = s0[2 * i]; a.y = s0[2 * i + 1];
                f32x2 b; b.x = s1[2 * i]; b.y = s1[2 * i + 1];
                a = a + nm; b = b + nm;
                s0[2 * i] = __builtin_amdgcn_exp2f(a.x); s0[2 * i + 1] = __builtin_amdgcn_exp2f(a.y);
                s1[2 * i] = __builtin_amdgcn_exp2f(b.x); s1[2 * i + 1] = __builtin_amdgcn_exp2f(b.y);
                ps += (s0[2 * i] + s1[2 * i]) + (s0[2 * i + 1] + s1[2 * i + 1]);
            }
            l += ps;
            const bf16x8 p00 = pack8(s0[0], s0[1], s0[2], s0[3], s0[4], s0[5], s0[6], s0[7]);
            const bf16x8 p01 = pack8(s0[8], s0[9], s0[10], s0[11], s0[12], s0[13], s0[14], s0[15]);
            const bf16x8 p10 = pack8(s1[0], s1[1], s1[2], s1[3], s1[4], s1[5], s1[6], s1[7]);
            const bf16x8 p11 = pack8(s1[8], s1[9], s1[10], s1[11], s1[12], s1[13], s1[14], s1[15]);
            if (!MLA) {
#pragma unroll
                for (int vt = 0; vt < NVT; ++vt)
#pragma unroll
                    for (int ms = 2; ms < 4; ++ms) vc[vt][ms - 2] = *(const u32x4*)(vb + vt * 32 * LROW + ms * 32);
            }
            __builtin_amdgcn_sched_barrier(0);
            __builtin_amdgcn_s_setprio(1);
#pragma unroll
            for (int ms = 0; ms < 2; ++ms)
#pragma unroll
                for (int vt = 0; vt < NVT; ++vt) o[vt] = MFMA32(__builtin_bit_cast(bf16x8, va[vt][ms]), ms ? p01 : p00, o[vt]);
#pragma unroll
            for (int ms = 0; ms < 2; ++ms)
#pragma unroll
                for (int vt = 0; vt < NVT; ++vt) o[vt] = MFMA32(__builtin_bit_cast(bf16x8, vc[vt][ms]), ms ? p11 : p10, o[vt]);
            __builtin_amdgcn_s_setprio(0);
        }
        __builtin_amdgcn_sched_barrier(0);
        if (kt + 1 < ntiles) {
            char* nb = lds + ((kt + 1) & 1) * BUF;
#pragma unroll
            for (int i = 0; i < NKC; ++i) { const int c = tid + NTHR * i, row = c / CPR, cc = c % CPR; if (c < 64 * CPR) *(u32x4*)(nb + row * KSTR + cc * 16) = rk[i]; }
#pragma unroll
            for (int i = 0; i < NVC; ++i) { const int c = tid + NTHR * i, row = c >> 3, cc = c & 7; char* d_ = nb + 64 * KSTR + row * LROW + (cc >> 1) * 32 + (cc & 1) * 8; u32x2 a_, b_; a_.x = rv[i].x; a_.y = rv[i].y; b_.x = rv[i].z; b_.y = rv[i].w; *(u32x2*)d_ = a_; *(u32x2*)(d_ + 16) = b_; }
        }
        __syncthreads();
    }
    l += xor32(l);
    linv = 1.f / l;
}

DI void phase_attn(const Params& p, char* lds, int* s_item, const int dry) {
    unsigned char* ws = p.ws;
    const int tid = threadIdx.x, wave = tid >> 6, lane = tid & 63, r = lane & 31, h = lane >> 5;
    unsigned* ctrl = (unsigned*)(ws + OFF_CTRL);
    const float lam = ((const float*)ctrl)[16];
    const float* subln = p.in[13];
    for (;;) {
        if (tid == 0) *s_item = (int)atomicAdd(&ctrl[dry ? 1 : 0], 1u);
        __syncthreads();
        const int item = *s_item;
        __syncthreads();
        if (item >= 768) break;
        if (item < 256) {
            const int qb = 15 - (item >> 4), b = (item >> 2) & 3, head = item & 3;
            const int q0 = qb * 256;
            const size_t tb = (size_t)b * S_;
            const u16* vt = (const u16*)(ws + R_DVT) + ((size_t)b * 512 + head * 128) * S_;
            f32x16 o[4]; float linv;
            attn_pass<false>((const u16*)(ws + R_DQ) + tb * 512 + head * 128 + 64, 512, (const u16*)(ws + R_DK) + tb * 512 + head * 128 + 64, 512, nullptr, vt, q0, lds, o, linv);
            const size_t t = tb + q0 + 32 * wave + r;
            u16* dst = (u16*)(ws + R_MIX0) + t * 1024 + 512 + head * 128;
#pragma unroll
            for (int v = 0; v < 4; ++v)
#pragma unroll
                for (int g = 0; g < 4; ++g) {
                    const int dv = v * 32 + 8 * g + 4 * h;
                    u32x2 st; st.x = pk2(o[v][4 * g] * linv, o[v][4 * g + 1] * linv); st.y = pk2(o[v][4 * g + 2] * linv, o[v][4 * g + 3] * linv);
                    if (!dry) *(u32x2*)(dst + dv) = st;
                }
            attn_pass<false>((const u16*)(ws + R_DQ) + tb * 512 + head * 128, 512, (const u16*)(ws + R_DK) + tb * 512 + head * 128, 512, nullptr, vt, q0, lds, o, linv);
            float ss = 0.f;
#pragma unroll
            for (int v = 0; v < 4; ++v)
#pragma unroll
                for (int g = 0; g < 4; ++g) {
                    const int dv = v * 32 + 8 * g + 4 * h;
                    const u32x2 o1 = *(const u32x2*)(dst + dv);
                    const float a0 = o[v][4 * g] * linv - lam * bflo(o1.x), a1 = o[v][4 * g + 1] * linv - lam * bfhi(o1.x);
                    const float a2 = o[v][4 * g + 2] * linv - lam * bflo(o1.y), a3 = o[v][4 * g + 3] * linv - lam * bfhi(o1.y);
                    o[v][4 * g] = a0; o[v][4 * g + 1] = a1; o[v][4 * g + 2] = a2; o[v][4 * g + 3] = a3;
                    ss += a0 * a0 + a1 * a1 + a2 * a2 + a3 * a3;
                }
            ss += xor32(ss);
            const float rs = rsqrtf(ss * (1.f / 128.f) + EPS) * 0.8f;
#pragma unroll
            for (int v = 0; v < 4; ++v)
#pragma unroll
                for (int g = 0; g < 4; ++g) {
                    const int dv = v * 32 + 8 * g + 4 * h;
                    const f32x4 w = *(const f32x4*)(subln + dv);
                    u32x2 st; st.x = pk2(o[v][4 * g] * rs * w.x, o[v][4 * g + 1] * rs * w.y); st.y = pk2(o[v][4 * g + 2] * rs * w.z, o[v][4 * g + 3] * rs * w.w);
                    if (!dry) *(u32x2*)(dst + dv) = st;
                }
        } else {
            const int j = item - 256;
            const int qb = 15 - (j >> 5), b = (j >> 3) & 3, head = j & 7;
            const int q0 = qb * 256;
            const size_t tb = (size_t)b * S_;
            f32x16 o[2]; float linv;
            attn_pass<true>((const u16*)(ws + R_QM) + tb * 768 + head * 96, 768, (const u16*)(ws + R_KN) + tb * 512 + head * 64, 512, (const u16*)(ws + R_KR) + tb * 32,
                            (const u16*)(ws + R_VMT) + ((size_t)b * 512 + head * 64) * S_, q0, lds, o, linv);
            const size_t t = tb + q0 + 32 * wave + r;
            u16* dst = (u16*)(ws + R_MIX0) + t * 1024 + head * 64;
#pragma unroll
            for (int v = 0; v < 2; ++v)
#pragma unroll
                for (int g = 0; g < 4; ++g) {
                    const int dv = v * 32 + 8 * g + 4 * h;
                    u32x2 st; st.x = pk2(o[v][4 * g] * linv, o[v][4 * g + 1] * linv); st.y = pk2(o[v][4 * g + 2] * linv, o[v][4 * g + 3] * linv);
                    if (!dry) *(u32x2*)(dst + dv) = st;
                }
        }
    }
}


DI void phase_inproj1(const Params& p, char* lds, const int dry) {
    unsigned char* ws = p.ws;
    const float* ssq = (const float*)(ws + SSQP_R) + (size_t)1 * T_ * 16;
    const float* lbt = (const float*)(ws + OFF_CTRL) + 64;
    const float* dt_bias = p.in[18];
    const int h = (threadIdx.x & 63) >> 5;
    auto epi = [&](int row, int cb, f32x16& c0, f32x16& c1) {
        if (dry) return;
        const float rs = rsqrtf(ssq_get16(ssq + (size_t)row * 16) * (1.f / 1024.f) + EPS);
        scale16(c0, rs); scale16(c1, rs);
        const int pos = row & (S_ - 1), b = row >> 12;
        if (cb < 512) {
#pragma unroll
            for (int i = 0; i < 16; ++i) { c0[i] = silu_f(c0[i]); c1[i] = silu_f(c1[i]); }
            u16* d = (u16*)(ws + R_ZS) + (size_t)row * 512 + cb + 16 * h;
            store_bf16x16(d, c0); store_bf16x16(d + 32, c1);
        } else if (cb < 1024) {
            u16* d = (u16*)(ws + R_XTRAW) + ((size_t)b * 512 + (cb - 512) + 16 * h) * S_ + pos;
            store_T16(d, c0); store_T16(d + (size_t)32 * S_, c1);
        } else if (cb < 1536) {
            u16* d = (u16*)(ws + R_BCRAW) + (size_t)row * 512 + (cb - 1024) + 16 * h;
            store_bf16x16(d, c0); store_bf16x16(d + 32, c1);
            if (cb < 1280) {
                u16* dT = (u16*)(ws + A_BTRAW) + ((size_t)b * 256 + (cb - 1024) + 16 * h) * S_ + pos;
                store_T16(dT, c0); store_T16(dT + (size_t)32 * S_, c1);
            }
        } else if (cb < 2048) {
#pragma unroll
            for (int i = 0; i < 16; ++i) { c0[i] = silu_f(c0[i]); c1[i] = silu_f(c1[i]); }
            u16* d = (u16*)(ws + R_HQT) + ((size_t)b * 512 + (cb - 1536) + 16 * h) * S_ + pos;
            store_T16(d, c0); store_T16(d + (size_t)32 * S_, c1);
        } else if (cb < 2560) {
            const int k0 = cb - 2048 + 16 * h;
            float* lf = (float*)(ws + R_LFT) + ((size_t)b * 512 + k0) * S_ + pos;
            u16* kt = (u16*)(ws + R_HKT) + ((size_t)b * 512 + k0) * S_ + pos;
#pragma unroll
            for (int half = 0; half < 2; ++half)
#pragma unroll
                for (int i = 0; i < 16; ++i) {
                    const int k = k0 + 32 * half + i;
                    const float lb = lbt[k];
                    const float x = half ? c1[i] : c0[i];
                    const float e = __expf(-x);
                    const float rcp = __builtin_amdgcn_rcpf(1.f + e);
                    const float f = lb + (1.f - lb) * rcp;
                    lf[(size_t)(32 * half + i) * S_] = __logf(f);
                    kt[(size_t)(32 * half + i) * S_] = f2bf((1.f - lb) * (e < 3.0e38f ? e * rcp : 1.f));
                }
        } else if (cb < 3072) {
            u16* d = (u16*)(ws + R_HVT) + ((size_t)b * 512 + (cb - 2560) + 16 * h) * S_ + pos;
            store_T16(d, c0); store_T16(d + (size_t)32 * S_, c1);
        } else if (cb < 3584) {
#pragma unroll
            for (int i = 0; i < 16; ++i) { c0[i] = silu_f(c0[i]); c1[i] = silu_f(c1[i]); }
            u16* d = (u16*)(ws + R_HG) + (size_t)row * 512 + (cb - 3072) + 16 * h;
            store_bf16x16(d, c0); store_bf16x16(d + 32, c1);
        } else if (cb == 3584) {
            if (h == 0) {
                float* d = (float*)(ws + R_DT) + (size_t)row * 8;
#pragma unroll
                for (int i = 0; i < 8; ++i) { const float x = c0[i] + dt_bias[i]; d[i] = (x > 20.f) ? x : log1pf(expf(x)); }
            }
        }
    };
    constexpr int NT = 15;
    { int mi, ni, hf; for (int rd = 0; tile_map(rd, NT, mi, ni, hf); ++rd) GEMM_DISPATCH((const u16*)(ws + OFF_XB), 1024, (const u16*)(ws + W_IN1), 1024, 1024, mi, ni * 256, hf, epi); }
}

DI void convT8(const u16* src, bool hist, float w0, float w1, float w2, float w3, float bias, float (&y)[8]) {
    const u32x4 cur = *(const u32x4*)src;
    u32x2 pv; pv.x = 0u; pv.y = 0u;
    if (hist) pv = *(const u32x2*)(src - 4);
    float x[11];
    x[0] = bfhi(pv.x); x[1] = bflo(pv.y); x[2] = bfhi(pv.y);
    x[3] = bflo(cur.x); x[4] = bfhi(cur.x); x[5] = bflo(cur.y); x[6] = bfhi(cur.y); x[7] = bflo(cur.z); x[8] = bfhi(cur.z); x[9] = bflo(cur.w); x[10] = bfhi(cur.w);
#pragma unroll
    for (int j = 0; j < 8; ++j) y[j] = silu_f(bias + w0 * x[j] + w1 * x[j + 1] + w2 * x[j + 2] + w3 * x[j + 3]);
}
DI void convT4(const u16* src, bool hist, float w0, float w1, float w2, float w3, float bias, float (&y)[4]) {
    const u32x2 cur = *(const u32x2*)src;
    u32x2 pv; pv.x = 0u; pv.y = 0u;
    if (hist) pv = *(const u32x2*)(src - 4);
    float x[7];
    x[0] = bfhi(pv.x); x[1] = bflo(pv.y); x[2] = bfhi(pv.y);
    x[3] = bflo(cur.x); x[4] = bfhi(cur.x); x[5] = bflo(cur.y); x[6] = bfhi(cur.y);
#pragma unroll
    for (int j = 0; j < 4; ++j) y[j] = silu_f(bias + w0 * x[j] + w1 * x[j + 1] + w2 * x[j + 2] + w3 * x[j + 3]);
}
DI bf16x8 convN8(const u16* src, int ld, int nh, const float* cw, const float* cb) {
    u32x4 x3 = *(const u32x4*)src, x2, x1, x0;
    x2.x = x2.y = x2.z = x2.w = 0u; x1 = x2; x0 = x2;
    if (nh >= 1) x2 = *(const u32x4*)(src - ld);
    if (nh >= 2) x1 = *(const u32x4*)(src - 2 * ld);
    if (nh >= 3) x0 = *(const u32x4*)(src - 3 * ld);
    float y[8];
#pragma unroll
    for (int q = 0; q < 2; ++q) {
        const f32x4 b = *(const f32x4*)(cb + 4 * q);
        const f32x4 t0 = *(const f32x4*)(cw + 4 * q), t1 = *(const f32x4*)(cw + 1024 + 4 * q), t2 = *(const f32x4*)(cw + 2048 + 4 * q), t3 = *(const f32x4*)(cw + 3072 + 4 * q);
        const unsigned a0 = q ? x0.z : x0.x, a0b = q ? x0.w : x0.y;
        const unsigned a1 = q ? x1.z : x1.x, a1b = q ? x1.w : x1.y;
        const unsigned a2 = q ? x2.z : x2.x, a2b = q ? x2.w : x2.y;
        const unsigned a3 = q ? x3.z : x3.x, a3b = q ? x3.w : x3.y;
        y[4 * q + 0] = silu_f(b.x + t0.x * bflo(a0) + t1.x * bflo(a1) + t2.x * bflo(a2) + t3.x * bflo(a3));
        y[4 * q + 1] = silu_f(b.y + t0.y * bfhi(a0) + t1.y * bfhi(a1) + t2.y * bfhi(a2) + t3.y * bfhi(a3));
        y[4 * q + 2] = silu_f(b.z + t0.z * bflo(a0b) + t1.z * bflo(a1b) + t2.z * bflo(a2b) + t3.z * bflo(a3b));
        y[4 * q + 3] = silu_f(b.w + t0.w * bfhi(a0b) + t1.w * bfhi(a1b) + t2.w * bfhi(a2b) + t3.w * bfhi(a3b));
    }
    return pack8(y[0], y[1], y[2], y[3], y[4], y[5], y[6], y[7]);
}

DI void ssd_tables(const Params& p, int b, int c, int g, float* tab, int tid) {
    const int hh = tid >> 6, lane = tid & 63;
    const int head = g * 4 + hh;
    const float A = -expf(p.in[19][head]);
    const float* dt = (const float*)(p.ws + R_DT) + ((size_t)b * S_ + c * 128) * 8 + head;
    const float d0 = dt[(2 * lane) * 8], d1 = dt[(2 * lane + 1) * 8];
    const float a0 = d0 * A, a1 = d1 * A;
    float incl = a0 + a1;
#pragma unroll
    for (int off = 1; off < 64; off <<= 1) { const float v = __shfl_up(incl, off, 64); if (lane >= off) incl += v; }
    tab[hh * 128 + 2 * lane] = d0; tab[hh * 128 + 2 * lane + 1] = d1;
    tab[512 + hh * 128 + 2 * lane] = incl - a1; tab[512 + hh * 128 + 2 * lane + 1] = incl;
}

DI void ssd_states_item(const Params& p, int it, char* lds, const int dry) {
    unsigned char* ws = p.ws;
    int tid = threadIdx.x;
    asm volatile("" : "+v"(tid));
    const int b = it >> 6, c = (it >> 1) & 31, g = it & 1;
    const int hh = (tid >> 6) & 3, nhalf = tid >> 8, lane = tid & 63, r = lane & 31, h = lane >> 5;
    float* tab = (float*)lds;
    __syncthreads();
    if (tid < 256) ssd_tables(p, b, c, g, tab, tid);
    __syncthreads();
    const int head = g * 4 + hh;
    const float alast = tab[512 + hh * 128 + 127];
    const float* cw = p.in[16];
    const float* cbias = p.in[17];
    bf16x8 af[2][8];
#pragma unroll
    for (int pt = 0; pt < 2; ++pt) {
        const int ch = g * 256 + hh * 64 + pt * 32 + r;
        const float w0 = cw[ch], w1 = cw[1024 + ch], w2 = cw[2048 + ch], w3 = cw[3072 + ch], bs = cbias[ch];
        const u16* src = (const u16*)(ws + R_XTRAW) + ((size_t)b * 512 + ch) * S_ + c * 128;
#pragma unroll
        for (int ks = 0; ks < 8; ++ks) {
            const int l0 = 16 * ks + 8 * h;
            float y[8];
            convT8(src + l0, (c * 128 + l0) > 0, w0, w1, w2, w3, bs, y);
#pragma unroll
            for (int j = 0; j < 8; ++j) y[j] *= tab[hh * 128 + l0 + j] * __expf(alast - tab[512 + hh * 128 + l0 + j]);
            af[pt][ks] = pack8(y[0], y[1], y[2], y[3], y[4], y[5], y[6], y[7]);
        }
    }
    u16* sst = (u16*)(ws + A_SST) + ((((size_t)b * 32 + c) * 8 + head) * 64) * 128;
#pragma unroll 1
    for (int nt2 = 0; nt2 < 2; ++nt2) {
        const int nt = 2 * nhalf + nt2;
        const int n = nt * 32 + r;
        const int chB = 512 + g * 128 + n;
        const float w0 = cw[chB], w1 = cw[1024 + chB], w2 = cw[2048 + chB], w3 = cw[3072 + chB], bs = cbias[chB];
        const u16* src = (const u16*)(ws + A_BTRAW) + ((size_t)b * 256 + g * 128 + n) * S_ + c * 128;
        f32x16 acc0 = zero16(), acc1 = zero16();
#pragma unroll
        for (int ks = 0; ks < 8; ++ks) {
            const int l0 = 16 * ks + 8 * h;
            float y[8];
            convT8(src + l0, (c * 128 + l0) > 0, w0, w1, w2, w3, bs, y);
            const bf16x8 bf = pack8(y[0], y[1], y[2], y[3], y[4], y[5], y[6], y[7]);
            acc0 = MFMA32(af[0][ks], bf, acc0);
            acc1 = MFMA32(af[1][ks], bf, acc1);
        }
#pragma unroll
        for (int i = 0; i < 16; ++i) {
            if (!dry) { sst[(size_t)(crow(i, h)) * 128 + n] = f2bf(acc0[i]);
            sst[(size_t)(32 + crow(i, h)) * 128 + n] = f2bf(acc1[i]); }
        }
    }
    if (lane == 0 && nhalf == 0 && !dry) ((float*)(ws + R_SDEC))[((size_t)b * 32 + c) * 8 + head] = __expf(alast);
}

DI void hg_states_item(const Params& p, int pair, char* lds, const int dry) {
    unsigned char* ws = p.ws;
    int tid = threadIdx.x;
    asm volatile("" : "+v"(tid));
    const int it = 2 * pair + (tid >> 8);
    lds += (tid >> 8) * 73728;
    tid &= 255;
    const int b = it >> 8, hd = (it >> 6) & 3, c = it & 63;
    const int w = tid >> 6, lane = tid & 63, r = lane & 31, h = lane >> 5;
    const int k = 32 * w + r, chan = hd * 128 + k;
    const size_t tbase = ((size_t)b * 512 + chan) * S_ + c * 64;
    const float* lf = (const float*)(ws + R_LFT) + tbase;
    const u16* hq = (const u16*)(ws + R_HQT) + tbase;
    const u16* hk = (const u16*)(ws + R_HKT) + tbase;
    float gc[4][8];
    float carry = 0.f;
#pragma unroll
    for (int ks = 0; ks < 4; ++ks) {
        const int l0 = 16 * ks + 8 * h;
        const f32x4 v0 = *(const f32x4*)(lf + l0), v1 = *(const f32x4*)(lf + l0 + 4);
        gc[ks][0] = v0.x; gc[ks][1] = gc[ks][0] + v0.y; gc[ks][2] = gc[ks][1] + v0.z; gc[ks][3] = gc[ks][2] + v0.w;
        gc[ks][4] = gc[ks][3] + v1.x; gc[ks][5] = gc[ks][4] + v1.y; gc[ks][6] = gc[ks][5] + v1.z; gc[ks][7] = gc[ks][6] + v1.w;
        const float tot = gc[ks][7], oth = xor32(tot);
        const float off = carry + (h ? oth : 0.f);
#pragma unroll
        for (int j = 0; j < 8; ++j) gc[ks][j] += off;
        carry += tot + oth;
    }
    const float glast = carry;
    bf16x8 bfr[4];
    u16* qs = ((u16*)p.out) + ((size_t)b * S_ + c * 64) * 512 + chan;
    u16* ksn = ((u16*)p.out + (size_t)T_ * 512) + ((size_t)b * S_ + c * 64) * 512 + chan;
#pragma unroll
    for (int ks = 0; ks < 4; ++ks) {
        const int l0 = 16 * ks + 8 * h;
        const u32x4 q8 = *(const u32x4*)(hq + l0), k8 = *(const u32x4*)(hk + l0);
        float qv[8], kv[8], kh[8];
        qv[0] = bflo(q8.x); qv[1] = bfhi(q8.x); qv[2] = bflo(q8.y); qv[3] = bfhi(q8.y); qv[4] = bflo(q8.z); qv[5] = bfhi(q8.z); qv[6] = bflo(q8.w); qv[7] = bfhi(q8.w);
        kv[0] = bflo(k8.x); kv[1] = bfhi(k8.x); kv[2] = bflo(k8.y); kv[3] = bfhi(k8.y); kv[4] = bflo(k8.z); kv[5] = bfhi(k8.z); kv[6] = bflo(k8.w); kv[7] = bfhi(k8.w);
#pragma unroll
        for (int j = 0; j < 8; ++j) {
            const float g = gc[ks][j];
            if (!dry) { qs[(size_t)(l0 + j) * 512] = f2bf(qv[j] * __expf(g));
            ksn[(size_t)(l0 + j) * 512] = f2bf(kv[j] * __expf(-g)); }
            kh[j] = kv[j] * __expf(glast - g);
        }
        bfr[ks] = pack8(kh[0], kh[1], kh[2], kh[3], kh[4], kh[5], kh[6], kh[7]);
    }
    if (h == 0 && !dry) ((float*)(ws + R_HDEC))[(((size_t)b * 4 + hd) * 64 + c) * 128 + k] = __expf(glast);
    u16* hs = (u16*)(ws + R_HS) + ((((size_t)b * 4 + hd) * 64 + c) * 128) * 128 + k;
    const u16* vt = (const u16*)(ws + R_HVT) + ((size_t)b * 512 + hd * 128 + r) * S_ + c * 64 + 8 * h;
    bf16x8 avf[4][4];
#pragma unroll
    for (int v4 = 0; v4 < 4; ++v4)
#pragma unroll
        for (int ks = 0; ks < 4; ++ks) avf[v4][ks] = *(const bf16x8*)(vt + (size_t)(v4 * 32) * S_ + 16 * ks);
#pragma unroll
    for (int v4 = 0; v4 < 4; ++v4) {
        f32x16 acc = zero16();
#pragma unroll
        for (int ks = 0; ks < 4; ++ks) acc = MFMA32(avf[v4][ks], bfr[ks], acc);
#pragma unroll
        for (int i = 0; i < 16; ++i) if (!dry) hs[(size_t)(v4 * 32 + crow(i, h)) * 128] = f2bf(acc[i]);
    }
}

DI void phase_states(const Params& p, char* lds, const int dry) {
    for (int it = blockIdx.x; it < 256 + 512; it += gridDim.x) {
        if (it < 256) ssd_states_item(p, it, lds, dry);
        else hg_states_item(p, it - 256, lds, dry);
    }
}

DI void phase_scan(const Params& p, char* lds, const int dry) {
    unsigned char* ws = p.ws;
    const int gtid = blockIdx.x * NTHR + threadIdx.x, gsz = gridDim.x * NTHR;
    for (int id = gtid; id < 131072; id += gsz) {
        if (id < 65536) {
            const int n4 = id & 31, pp = (id >> 5) & 63, head = (id >> 11) & 7, b = id >> 14;
            u16* base = (u16*)(ws + A_SST) + (((size_t)b * 32 * 8 + head) * 64 + pp) * 128 + 4 * n4;
            const float* dec = (const float*)(ws + R_SDEC) + (size_t)b * 32 * 8 + head;
            float h0 = 0.f, h1 = 0.f, h2 = 0.f, h3 = 0.f;
            for (int c0 = 0; c0 < 32; c0 += 16) {
                u32x2 sv[16]; float dv[16];
#pragma unroll
                for (int u = 0; u < 16; ++u) { sv[u] = *(const u32x2*)(base + (size_t)(c0 + u) * 8 * 64 * 128); dv[u] = dec[(c0 + u) * 8]; }
#pragma unroll
                for (int u = 0; u < 16; ++u) {
                    u32x2 o; o.x = pk2(h0, h1); o.y = pk2(h2, h3);
                    if (!dry) *(u32x2*)(base + (size_t)(c0 + u) * 8 * 64 * 128) = o;
                    h0 = dv[u] * h0 + bflo(sv[u].x); h1 = dv[u] * h1 + bfhi(sv[u].x); h2 = dv[u] * h2 + bflo(sv[u].y); h3 = dv[u] * h3 + bfhi(sv[u].y);
                }
            }
        } else {
            const int j = id - 65536;
            const int k4 = j & 31, v = (j >> 5) & 127, hd = (j >> 12) & 3, b = j >> 14;
            u16* base = (u16*)(ws + R_HS) + ((((size_t)b * 4 + hd) * 64) * 128 + v) * 128 + 4 * k4;
            const float* dec = (const float*)(ws + R_HDEC) + (((size_t)b * 4 + hd) * 64) * 128 + 4 * k4;
            float h0 = 0.f, h1 = 0.f, h2 = 0.f, h3 = 0.f;
            for (int c0 = 0; c0 < 64; c0 += 16) {
                u32x2 sv[16]; f32x4 dv[16];
#pragma unroll
                for (int u = 0; u < 16; ++u) { sv[u] = *(const u32x2*)(base + (size_t)(c0 + u) * 128 * 128); dv[u] = *(const f32x4*)(dec + (size_t)(c0 + u) * 128); }
#pragma unroll
                for (int u = 0; u < 16; ++u) {
                    u32x2 o; o.x = pk2(h0, h1); o.y = pk2(h2, h3);
                    if (!dry) *(u32x2*)(base + (size_t)(c0 + u) * 128 * 128) = o;
                    h0 = dv[u].x * h0 + bflo(sv[u].x); h1 = dv[u].y * h1 + bfhi(sv[u].x); h2 = dv[u].z * h2 + bflo(sv[u].y); h3 = dv[u].w * h3 + bfhi(sv[u].y);
                }
            }
        }
    }
    convert_jobs(p, 8, 10, lds, dry);
}

DI void ssd_out_item(const Params& p, int it, char* lds, const int dry) {
    unsigned char* ws = p.ws;
    int tid = threadIdx.x;
    asm volatile("" : "+v"(tid));
    const int b = it >> 6, c = (it >> 1) & 31, g = it & 1;
    const int w = (tid >> 6) & 3, hsel = tid >> 8, lane = tid & 63, r = lane & 31, h = lane >> 5;
    float* tab = (float*)lds;
    __syncthreads();
    if (tid < 256) ssd_tables(p, b, c, g, tab, tid);
    const float* cw = p.in[16];
    const float* cbias = p.in[17];
    const int l = 32 * w + r;
    const size_t t = (size_t)b * S_ + c * 128 + l;
    const u16* bc = (const u16*)(ws + R_BCRAW);
    constexpr int BCROW = 272;
    char* Bs = lds + 4096;
    char* Cs = Bs + 128 * BCROW;
    char* Xs = Cs + 128 * BCROW;
    {
        const int cc = tid & 15;
#pragma unroll
        for (int i = 0; i < 4; ++i) {
            const int ll = (tid >> 4) + 32 * i;
            const size_t tt = (size_t)b * S_ + c * 128 + ll;
            const int nh = min(3, c * 128 + ll);
            *(bf16x8*)(Bs + ll * BCROW + cc * 16) = convN8(bc + tt * 512 + g * 128 + 8 * cc, 512, nh, cw + 512 + g * 128 + 8 * cc, cbias + 512 + g * 128 + 8 * cc);
            *(bf16x8*)(Cs + ll * BCROW + cc * 16) = convN8(bc + tt * 512 + 256 + g * 128 + 8 * cc, 512, nh, cw + 768 + g * 128 + 8 * cc, cbias + 768 + g * 128 + 8 * cc);
        }
    }
    {
        const int sc = tid & 15;
#pragma unroll 4
        for (int i = 0; i < 8; ++i) {
            const int chl = (tid >> 4) + 32 * i;
            const int ch = g * 256 + chl;
            const float w0 = cw[ch], w1 = cw[1024 + ch], w2 = cw[2048 + ch], w3 = cw[3072 + ch], bs = cbias[ch];
            const u16* src = (const u16*)(ws + R_XTRAW) + ((size_t)b * 512 + ch) * S_ + c * 128 + 8 * sc;
            float y[8];
            convT8(src, (c * 128 + 8 * sc) > 0, w0, w1, w2, w3, bs, y);
            *(bf16x8*)(Xs + chl * BCROW + sc * 16) = pack8(y[0], y[1], y[2], y[3], y[4], y[5], y[6], y[7]);
        }
    }
    __syncthreads();
    unsigned Xp[4][8];
    {
        bf16x8 cf[8];
#pragma unroll
        for (int ks = 0; ks < 8; ++ks) cf[ks] = *(const bf16x8*)(Cs + l * BCROW + ks * 32 + h * 16);
#pragma unroll
        for (int st = 0; st < 4; ++st) {
            f32x16 X = zero16();
            if (st <= w) {
#pragma unroll
                for (int ks = 0; ks < 8; ++ks) {
                    const bf16x8 bfr = *(const bf16x8*)(Bs + (32 * st + r) * BCROW + ks * 32 + h * 16);
                    X = MFMA32(bfr, cf[ks], X);
                }
            }
#pragma unroll
            for (int i = 0; i < 8; ++i) Xp[st][i] = pk2(X[2 * i], X[2 * i + 1]);
        }
    }
    const u16* zs = (const u16*)(ws + R_ZS) + t * 512 + g * 256;
    u16* dst = (u16*)(ws + R_MIX1) + t * 1024 + g * 256;
    float ss = 0.f;
#pragma unroll 1
    for (int hq = 0; hq < 2; ++hq) {
        const int hh = 2 * hsel + hq;
        const int head = g * 4 + hh;
        f32x16 acc0 = zero16(), acc1 = zero16();
        {
            const u16* prev = (const u16*)(ws + A_SST) + ((((size_t)b * 32 + c) * 8 + head) * 64 + r) * 128 + 8 * h;
            int opq = 0;
            asm volatile("" : "+v"(opq));
            const char* Cl = Cs + l * BCROW + h * 16 + opq;
            bf16x8 pf0[8], pf1[8];
#pragma unroll
            for (int ks = 0; ks < 8; ++ks) { pf0[ks] = *(const bf16x8*)(prev + 16 * ks); pf1[ks] = *(const bf16x8*)(prev + (size_t)32 * 128 + 16 * ks); }
            __builtin_amdgcn_sched_barrier(0);
#pragma unroll
            for (int ks = 0; ks < 8; ++ks) {
                const bf16x8 cfk = *(const bf16x8*)(Cl + ks * 32);
                acc0 = MFMA32(pf0[ks], cfk, acc0);
                acc1 = MFMA32(pf1[ks], cfk, acc1);
            }
            const float el = __expf(tab[512 + hh * 128 + l]);
            scale16(acc0, el); scale16(acc1, el);
        }
        const float al = tab[512 + hh * 128 + l];
        const float Dh = p.in[20][head];
        const char* x0 = Xs + (hh * 64 + r) * BCROW + 8 * h;
        const float* tdt = tab + hh * 128 + 4 * h;
        const float* tac = tab + 512 + hh * 128 + 4 * h;
#pragma unroll
        for (int st = 0; st < 4; ++st) {
            if (st <= w) {
                float mm[16];
#pragma unroll
                for (int i = 0; i < 16; ++i) {
                    const int so = 32 * st + (i & 3) + 8 * (i >> 2);
                    float m = ((i & 1) ? bfhi(Xp[st][i >> 1]) : bflo(Xp[st][i >> 1])) * tdt[so] * __expf(al - tac[so]);
                    const int s = so + 4 * h;
                    if (s > l) m = 0.f;
                    if (s == l) m += Dh;
                    mm[i] = m;
                }
                const bf16x8 p0 = pack8(mm[0], mm[1], mm[2], mm[3], mm[4], mm[5], mm[6], mm[7]);
                const bf16x8 p1 = pack8(mm[8], mm[9], mm[10], mm[11], mm[12], mm[13], mm[14], mm[15]);
#pragma unroll
                for (int sub = 0; sub < 2; ++sub) {
                    const int so = (32 * st + 16 * sub) * 2;
                    const u32x2 a0 = *(const u32x2*)(x0 + so), a1 = *(const u32x2*)(x0 + so + 16);
                    const u32x2 b0 = *(const u32x2*)(x0 + 32 * BCROW + so), b1 = *(const u32x2*)(x0 + 32 * BCROW + so + 16);
                    u32x4 va, vb; va.x = a0.x; va.y = a0.y; va.z = a1.x; va.w = a1.y; vb.x = b0.x; vb.y = b0.y; vb.z = b1.x; vb.w = b1.y;
                    acc0 = MFMA32(__builtin_bit_cast(bf16x8, va), sub ? p1 : p0, acc0);
                    acc1 = MFMA32(__builtin_bit_cast(bf16x8, vb), sub ? p1 : p0, acc1);
                }
            }
        }
#pragma unroll
        for (int pt = 0; pt < 2; ++pt)
#pragma unroll
            for (int q = 0; q < 4; ++q) {
                const int cc = hh * 64 + pt * 32 + 8 * q + 4 * h;
                const u32x2 z = *(const u32x2*)(zs + cc);
                const float y0 = (pt ? acc1[4 * q] : acc0[4 * q]) * bflo(z.x), y1 = (pt ? acc1[4 * q + 1] : acc0[4 * q + 1]) * bfhi(z.x);
                const float y2 = (pt ? acc1[4 * q + 2] : acc0[4 * q + 2]) * bflo(z.y), y3 = (pt ? acc1[4 * q + 3] : acc0[4 * q + 3]) * bfhi(z.y);
                ss += y0 * y0 + y1 * y1 + y2 * y2 + y3 * y3;
                u32x2 o; o.x = pk2(y0, y1); o.y = pk2(y2, y3);
                if (!dry) *(u32x2*)(dst + cc) = o;
            }
    }
    ss += xor32(ss);
    __syncthreads();
    if (h == 0) ((float*)Bs)[(hsel * 4 + w) * 32 + r] = ss;
    __syncthreads();
    ss += ((const float*)Bs)[((hsel ^ 1) * 4 + w) * 32 + r];
    const float rs = rsqrtf(ss * (1.f / 256.f) + EPS);
    const float* nw = p.in[21] + g * 256;
#pragma unroll 1
    for (int hq = 0; hq < 2; ++hq)
#pragma unroll
        for (int pq = 0; pq < 8; ++pq) {
            const int cc = (2 * hsel + hq) * 64 + (pq >> 2) * 32 + 8 * (pq & 3) + 4 * h;
            const f32x4 wv = *(const f32x4*)(nw + cc);
            const u32x2 y = *(const u32x2*)(dst + cc);
            u32x2 o; o.x = pk2(bflo(y.x) * rs * wv.x, bfhi(y.x) * rs * wv.y); o.y = pk2(bflo(y.y) * rs * wv.z, bfhi(y.y) * rs * wv.w);
            if (!dry) *(u32x2*)(dst + cc) = o;
        }
}

DI void hg_out_item(const Params& p, int pair, char* lds, const int dry) {
    unsigned char* ws = p.ws;
    int tid = threadIdx.x;
    asm volatile("" : "+v"(tid));
    const int it = 2 * pair + (tid >> 8);
    lds += (tid >> 8) * 73728;
    tid &= 255;
    const int b = it >> 8, hd = (it >> 6) & 3, c = it & 63;
    const int w = tid >> 6, lane = tid & 63, r = lane & 31, h = lane >> 5;
    const int lt = w & 1, vh = w >> 1;
    const int l = 32 * lt + r;
    const size_t t0 = (size_t)b * S_ + c * 64;
    const size_t t = t0 + l;
    bf16x8 qf[8];
    {
        const u16* qs = ((const u16*)p.out) + t * 512 + hd * 128 + 8 * h;
#pragma unroll
        for (int ks = 0; ks < 8; ++ks) qf[ks] = *(const bf16x8*)(qs + 16 * ks);
    }
    f32x16 acc[2];
    {
        const u16* prev = (const u16*)(ws + R_HS) + ((((size_t)b * 4 + hd) * 64 + c) * 128 + vh * 64 + r) * 128 + 8 * h;
        bf16x8 pf[2][8];
#pragma unroll
        for (int v2 = 0; v2 < 2; ++v2)
#pragma unroll
            for (int ks = 0; ks < 8; ++ks) pf[v2][ks] = *(const bf16x8*)(prev + (size_t)(v2 * 32) * 128 + 16 * ks);
        __builtin_amdgcn_sched_barrier(0);
        acc[0] = zero16(); acc[1] = zero16();
#pragma unroll
        for (int ks = 0; ks < 8; ++ks) { acc[0] = MFMA32(pf[0][ks], qf[ks], acc[0]); acc[1] = MFMA32(pf[1][ks], qf[ks], acc[1]); }
    }
    for (int st = 0; st <= lt; ++st) {
        f32x16 X = zero16();
        u32x2 vlo[2][2], vhi[2][2];
        {
            const u16* kk = ((const u16*)p.out + (size_t)T_ * 512) + (t0 + 32 * st + r) * 512 + hd * 128 + 8 * h;
            bf16x8 kf[8];
#pragma unroll
            for (int ks = 0; ks < 8; ++ks) kf[ks] = *(const bf16x8*)(kk + 16 * ks);
#pragma unroll
            for (int v2 = 0; v2 < 2; ++v2) {
                const u16* vt = (const u16*)(ws + R_HVT) + ((size_t)b * 512 + hd * 128 + vh * 64 + v2 * 32 + r) * S_ + c * 64 + 32 * st + 4 * h;
#pragma unroll
                for (int sub = 0; sub < 2; ++sub) { vlo[v2][sub] = *(const u32x2*)(vt + 16 * sub); vhi[v2][sub] = *(const u32x2*)(vt + 16 * sub + 8); }
            }
            __builtin_amdgcn_sched_barrier(0);
#pragma unroll
            for (int ks = 0; ks < 8; ++ks) X = MFMA32(kf[ks], qf[ks], X);
        }
        float mm[16];
#pragma unroll
        for (int i = 0; i < 16; ++i) { const int s = 32 * st + crow(i, h); mm[i] = (s > l) ? 0.f : X[i]; }
        const bf16x8 p0 = pack8(mm[0], mm[1], mm[2], mm[3], mm[4], mm[5], mm[6], mm[7]);
        const bf16x8 p1 = pack8(mm[8], mm[9], mm[10], mm[11], mm[12], mm[13], mm[14], mm[15]);
#pragma unroll
        for (int v2 = 0; v2 < 2; ++v2) {
#pragma unroll
            for (int sub = 0; sub < 2; ++sub) {
                u32x4 vv; vv.x = vlo[v2][sub].x; vv.y = vlo[v2][sub].y; vv.z = vhi[v2][sub].x; vv.w = vhi[v2][sub].y;
                acc[v2] = MFMA32(__builtin_bit_cast(bf16x8, vv), sub ? p1 : p0, acc[v2]);
            }
        }
    }
    float ss = sumsq16(acc[0]) + sumsq16(acc[1]);
    ss += xor32(ss);
    float* xch = (float*)lds;
    __syncthreads();
    if (h == 0) xch[w * 32 + r] = ss;
    __syncthreads();
    ss += xch[(w ^ 2) * 32 + r];
    const float rs = rsqrtf(ss * (1.f / 128.f) + EPS);
    const float* gn = p.in[22];
    const u16* hg = (const u16*)(ws + R_HG) + t * 512 + hd * 128;
    u16* dst = (u16*)(ws + R_MIX1) + t * 1024 + 512 + hd * 128;
#pragma unroll
    for (int v2 = 0; v2 < 2; ++v2)
#pragma unroll
        for (int q = 0; q < 4; ++q) {
            const int vv = vh * 64 + v2 * 32 + 8 * q + 4 * h;
            const f32x4 wv = *(const f32x4*)(gn + vv);
            const u32x2 gg = *(const u32x2*)(hg + vv);
            u32x2 o;
            o.x = pk2(acc[v2][4 * q] * rs * wv.x * bflo(gg.x), acc[v2][4 * q + 1] * rs * wv.y * bfhi(gg.x));
            o.y = pk2(acc[v2][4 * q + 2] * rs * wv.z * bflo(gg.y), acc[v2][4 * q + 3] * rs * wv.w * bfhi(gg.y));
            if (!dry) *(u32x2*)(dst + vv) = o;
        }
}

DI void phase_outputs(const Params& p, char* lds, const int dry) {
    for (int it = blockIdx.x; it < 256 + 512; it += gridDim.x) {
        if (it < 256) ssd_out_item(p, it, lds, dry);
        else hg_out_item(p, it - 256, lds, dry);
    }
}

DI void phase_final(const Params& p) {
    const int tid = threadIdx.x, lane = tid & 63;
    const int gw = (blockIdx.x * NTHR + tid) >> 6, nw = (gridDim.x * NTHR) >> 6;
    const float* ssq = (const float*)(p.ws + SSQP_R) + (size_t)3 * T_ * 16;
    const float* wn = p.in[3];
    const u16* xb = (const u16*)(p.ws + OFF_XB);
    for (int row0 = gw * 2; row0 < T_; row0 += nw * 2) {
        u32x4 v[2][2];
#pragma unroll
        for (int rr = 0; rr < 2; ++rr)
#pragma unroll
            for (int jj = 0; jj < 2; ++jj) v[rr][jj] = *(const u32x4*)(xb + (size_t)(row0 + rr) * 1024 + jj * 512 + lane * 8);
#pragma unroll
        for (int rr = 0; rr < 2; ++rr) {
            const float rs = rsqrtf(ssq_get16(ssq + (size_t)(row0 + rr) * 16) * (1.f / 1024.f) + EPS);
#pragma unroll
            for (int jj = 0; jj < 2; ++jj) {
                const f32x4 w0 = *(const f32x4*)(wn + jj * 512 + lane * 8), w1 = *(const f32x4*)(wn + jj * 512 + lane * 8 + 4);
                const u32x4 q = v[rr][jj];
                f32x4 o0, o1;
                o0.x = bflo(q.x) * rs * w0.x; o0.y = bfhi(q.x) * rs * w0.y; o0.z = bflo(q.y) * rs * w0.z; o0.w = bfhi(q.y) * rs * w0.w;
                o1.x = bflo(q.z) * rs * w1.x; o1.y = bfhi(q.z) * rs * w1.y; o1.z = bflo(q.w) * rs * w1.z; o1.w = bfhi(q.w) * rs * w1.w;
                float* dst = p.out + (size_t)(row0 + rr) * 1024 + jj * 512 + lane * 8;
                *(f32x4*)dst = o0; *(f32x4*)(dst + 4) = o1;
            }
        }
    }
}

#ifndef PROBE
#define PROBE 0
#endif
constexpr int LDS_BYTES = GEMM_LDS;
#define RUN_PHASE(k, call_dry, call) do { if (PROBE == (k)) { int dry = 1; asm volatile("" : "+s"(dry)); call_dry; xcd_barrier(xb); } { constexpr int dry = 0; call; } } while (0)
__global__ void __launch_bounds__(NTHR, 2) fwd_kernel(Params p) {
    extern __shared__ __attribute__((aligned(16))) char lds[];
    __shared__ uint4 xb_words;
    if (threadIdx.x == 0) xb_words = make_uint4(0u, 0u, 0u, 0u);
    __syncthreads();
    int* s_item_p = (int*)&xb_words + 2;
    cg::grid_group grid = cg::this_grid();
    unsigned char* ws = p.ws;
    float* ssqr = (float*)(ws + SSQP_R);
    if (p.ws == nullptr) grid.sync();
    const XcdBarrier xb = xcd_barrier_post((unsigned*)(ws + OFF_BAR), (volatile LAS unsigned*)&xb_words);
    { constexpr int dry = 0; phase0(p, lds, dry); }
    if (PROBE == 1) { xcd_barrier(xb); int dry = 1; asm volatile("" : "+s"(dry)); phase0(p, lds, dry); }
    xcd_barrier(xb);
    RUN_PHASE(2, phase_inproj0(p, lds, dry), phase_inproj0(p, lds, dry));
    xcd_barrier(xb);
    RUN_PHASE(3, phase_upproj0(p, lds, dry), phase_upproj0(p, lds, dry));
    xcd_barrier(xb);
    RUN_PHASE(4, phase_attn(p, lds, s_item_p, dry), phase_attn(p, lds, s_item_p, dry));
    xcd_barrier(xb);
    RUN_PHASE(5, phase_resid(p, lds, (const u16*)(ws + R_MIX0), 1024, (const u16*)(ws + W_OUT0), ssqr, dry),
              phase_resid(p, lds, (const u16*)(ws + R_MIX0), 1024, (const u16*)(ws + W_OUT0), ssqr, dry));
    xcd_barrier(xb);
    RUN_PHASE(6, phase_ffn_up(p, lds, (const u16*)(ws + W_GU0), ssqr, dry), phase_ffn_up(p, lds, (const u16*)(ws + W_GU0), ssqr, dry));
    xcd_barrier(xb);
    RUN_PHASE(7, phase_resid(p, lds, (const u16*)(ws + R_H), 2816, (const u16*)(ws + W_D0), ssqr + (size_t)1 * T_ * 16, dry),
              phase_resid(p, lds, (const u16*)(ws + R_H), 2816, (const u16*)(ws + W_D0), ssqr + (size_t)1 * T_ * 16, dry));
    xcd_barrier(xb);
    RUN_PHASE(8, phase_inproj1(p, lds, dry), phase_inproj1(p, lds, dry));
    xcd_barrier(xb);
    RUN_PHASE(9, phase_states(p, lds, dry), phase_states(p, lds, dry));
    xcd_barrier(xb);
    RUN_PHASE(10, phase_scan(p, lds, dry), phase_scan(p, lds, dry));
    xcd_barrier(xb);
    RUN_PHASE(11, phase_outputs(p, lds, dry), phase_outputs(p, lds, dry));
    xcd_barrier(xb);
    { constexpr int dry = 0; phase_resid(p, lds, (const u16*)(ws + R_MIX1), 1024, (const u16*)(ws + W_OUT1), ssqr + (size_t)2 * T_ * 16, dry); }
    xcd_barrier(xb);
    { constexpr int dry = 0; phase_ffn_up(p, lds, (const u16*)(ws + W_GU1), ssqr + (size_t)2 * T_ * 16, dry); }
    xcd_barrier(xb);
    { constexpr int dry = 0; phase_resid(p, lds, (const u16*)(ws + R_H), 2816, (const u16*)(ws + W_D1), ssqr + (size_t)3 * T_ * 16, dry); }
    xcd_barrier(xb);
    phase_final(p);
    if (PROBE == 12) { for (int i = 0; i < 10; ++i) xcd_barrier(xb); }
}

extern "C" void kernel_launch(void* const* d_in, const int* in_sizes, int n_in, void* d_out, int out_size, void* d_ws, size_t ws_size, hipStream_t stream) {
    static int grid_blocks = 0;
    if (grid_blocks == 0) {
        if (n_in != 28 || out_size != T_ * 1024 || ws_size < WS_END2) {
            fprintf(stderr, "kernel_launch: unexpected problem (n_in %d, out %d, ws %zu need %zu)\n", n_in, out_size, ws_size, (size_t)WS_END2);
            grid_blocks = -1; return;
        }
        int dev = 0, cus = 0, per_cu = 0;
        hipGetDevice(&dev);
        hipDeviceGetAttribute(&cus, hipDeviceAttributeMultiprocessorCount, dev);
        hipFuncSetAttribute((const void*)fwd_kernel, hipFuncAttributeMaxDynamicSharedMemorySize, LDS_BYTES);
        hipOccupancyMaxActiveBlocksPerMultiprocessor(&per_cu, (const void*)fwd_kernel, NTHR, LDS_BYTES);
        if (per_cu < 1) { fprintf(stderr, "kernel_launch: occupancy query says %d blocks per CU\n", per_cu); per_cu = 1; }
        if (per_cu > 1) per_cu = 1;
        grid_blocks = (cus * per_cu) & ~7;
        fprintf(stderr, "kernel_launch: %d CUs x %d blocks\n", cus, per_cu);
    }
    if (grid_blocks < 0) return;
    if (hipMemsetAsync((char*)d_ws + OFF_CTRL, 0, OFF_SSQ, stream) != hipSuccess) { fprintf(stderr, "kernel_launch: memset of the control words failed\n"); return; }
    Params p{};
    for (int i = 0; i < 28; ++i) p.in[i] = (const float*)d_in[i];
    p.out = (float*)d_out;
    p.ws = (unsigned char*)d_ws;
    void* args[] = {&p};
    hipError_t e = hipLaunchCooperativeKernel((const void*)fwd_kernel, dim3(grid_blocks), dim3(NTHR), args, LDS_BYTES, stream);
    if (e != hipSuccess) fprintf(stderr, "cooperative launch failed: %s (grid %d)\n", hipGetErrorString(e), grid_blocks);
}
```

```cpp
#include <hip/hip_runtime.h>
#include <hip/hip_cooperative_groups.h>
#include <cstdio>
#include <cstdint>
namespace cg = cooperative_groups;

#define DI __device__ __forceinline__
typedef unsigned short u16;
typedef short bf16x8 __attribute__((ext_vector_type(8)));
typedef float f32x16 __attribute__((ext_vector_type(16)));
typedef float f32x4 __attribute__((ext_vector_type(4)));
typedef float f32x2 __attribute__((ext_vector_type(2)));
typedef unsigned u32x4 __attribute__((ext_vector_type(4)));
typedef unsigned u32x2 __attribute__((ext_vector_type(2)));
typedef __bf16 bf2_t __attribute__((ext_vector_type(2)));

constexpr int T_ = 16384, S_ = 4096, NBATCH = 4;
constexpr int NTHR = 512;
#define GVAR 0
constexpr float EPS = 1e-6f;
constexpr float LOG2E = 1.4426950408889634f;

constexpr size_t OFF_CTRL = 0;
constexpr size_t OFF_BAR = 4096;
constexpr size_t OFF_SSQ = 32768;
constexpr size_t OFF_ROPED = OFF_SSQ + 8 * 65536;
constexpr size_t OFF_ROPEM = OFF_ROPED + (size_t)S_ * 32 * 8;
constexpr size_t OFF_WA = 2u << 20;
constexpr size_t W_IN0 = OFF_WA;
constexpr size_t W_UQ = W_IN0 + 2304u * 1024 * 2;
constexpr size_t W_UKV = W_UQ + 768u * 384 * 2;
constexpr size_t W_OUT0 = W_UKV + 1024u * 256 * 2;
constexpr size_t W_GU0 = W_OUT0 + 1024u * 1024 * 2;
constexpr size_t W_D0 = W_GU0 + 5632u * 1024 * 2;
constexpr size_t OFF_WA_END = W_D0 + 1024u * 2816 * 2;
constexpr size_t A_BTRAW = OFF_WA;
constexpr size_t A_SST = A_BTRAW + (size_t)NBATCH * 256 * S_ * 2;
static_assert(A_SST + (size_t)NBATCH * 32 * 8 * 64 * 128 * 2 <= OFF_WA_END, "alias");
constexpr size_t W_IN1 = OFF_WA_END;
constexpr size_t W_OUT1 = W_IN1 + 3840u * 1024 * 2;
constexpr size_t OFF_XB = W_OUT1 + 1024u * 1024 * 2;
constexpr size_t OFF_R = OFF_XB + (size_t)T_ * 1024 * 2;
constexpr size_t R_CQ = OFF_R;
constexpr size_t R_CKV = R_CQ + (size_t)T_ * 384 * 2;
constexpr size_t R_KR = R_CKV + (size_t)T_ * 256 * 2;
constexpr size_t R_DQ = R_KR + (size_t)T_ * 32 * 2;
constexpr size_t R_DK = R_DQ + (size_t)T_ * 512 * 2;
constexpr size_t R_DVT = R_DK + (size_t)T_ * 512 * 2;
constexpr size_t R_QM = R_DVT + (size_t)T_ * 512 * 2;
constexpr size_t R_KN = R_QM + (size_t)T_ * 768 * 2;
constexpr size_t R_VMT = R_KN + (size_t)T_ * 512 * 2;
constexpr size_t R_MIX0 = R_VMT + (size_t)T_ * 512 * 2;
constexpr size_t R_H = OFF_R;
constexpr size_t R_ZS = OFF_R;
constexpr size_t R_XTRAW = R_ZS + (size_t)T_ * 512 * 2;
constexpr size_t R_BCRAW = R_XTRAW + (size_t)T_ * 512 * 2;
constexpr size_t R_HVT = R_BCRAW + (size_t)T_ * 512 * 2;
constexpr size_t R_HG = R_HVT + (size_t)T_ * 512 * 2;
constexpr size_t R_DT = R_HG + (size_t)T_ * 512 * 2;
constexpr size_t R_LFT = R_DT + (size_t)T_ * 8 * 4;
constexpr size_t R_MIX1 = R_LFT;
constexpr size_t R_HQT = R_LFT + (size_t)T_ * 512 * 4;
constexpr size_t R_HKT = R_HQT + (size_t)T_ * 512 * 2;
constexpr size_t W_GU1 = R_HQT;
constexpr size_t W_D1 = W_GU1 + 5632u * 1024 * 2;
static_assert(W_D1 + 1024u * 2816 * 2 <= R_HKT + (size_t)T_ * 512 * 2, "alias");
static_assert(W_GU1 >= R_H + (size_t)T_ * 2816 * 2, "alias H");
constexpr size_t R_HS = R_HKT + (size_t)T_ * 512 * 2;
constexpr size_t R_SDEC = R_HS + (size_t)NBATCH * 4 * 64 * 128 * 128 * 2;
constexpr size_t R_HDEC = R_SDEC + 4096;
constexpr size_t WS_END = R_HDEC + (size_t)NBATCH * 4 * 64 * 128 * 4;
static_assert(R_MIX0 + (size_t)T_ * 1024 * 2 <= WS_END, "size");
constexpr size_t SSQP_Q = WS_END;
constexpr size_t SSQP_KV = SSQP_Q + (size_t)T_ * 8 * 4;
constexpr size_t SSQP_R = SSQP_KV + (size_t)T_ * 4 * 4;
constexpr size_t WS_END2 = SSQP_R + 4 * (size_t)T_ * 16 * 4;
static_assert(WS_END2 <= 268435456u, "workspace");
static_assert(WS_END <= 268435456u, "workspace");

struct Params {
    const float* in[28];
    float* out;
    unsigned char* ws;
};

DI unsigned pk2(float lo, float hi) { bf2_t v; v.x = (__bf16)lo; v.y = (__bf16)hi; return __builtin_bit_cast(unsigned, v); }
DI u16 f2bf(float x) { __bf16 b = (__bf16)x; return __builtin_bit_cast(u16, b); }
DI float bflo(unsigned u) { return __uint_as_float(u << 16); }
DI float bfhi(unsigned u) { return __uint_as_float(u & 0xffff0000u); }
DI float bf2f(u16 v) { return __uint_as_float(((unsigned)v) << 16); }
DI float silu_f(float x) { return x * __builtin_amdgcn_rcpf(1.f + __expf(-x)); }
DI float xor32(float v) {
    const auto r = __builtin_amdgcn_permlane32_swap(__float_as_uint(v), __float_as_uint(v), false, false);
    return __uint_as_float((threadIdx.x & 32) ? r[0] : r[1]);
}
#define MFMA32(a, b, c) __builtin_amdgcn_mfma_f32_32x32x16_bf16((a), (b), (c), 0, 0, 0)
DI int crow(int i, int h) { return (i & 3) + 8 * (i >> 2) + 4 * h; }
DI int perm32(int r) { return 16 * ((r >> 2) & 1) + 4 * (r >> 3) + (r & 3); }
DI f32x16 zero16() { f32x16 z; for (int i = 0; i < 16; ++i) z[i] = 0.f; return z; }
DI bf16x8 pack8(float a0, float a1, float a2, float a3, float a4, float a5, float a6, float a7) {
    u32x4 p; p.x = pk2(a0, a1); p.y = pk2(a2, a3); p.z = pk2(a4, a5); p.w = pk2(a6, a7); return __builtin_bit_cast(bf16x8, p);
}
DI void store_bf16x16(u16* dst, const f32x16& v) {
    u32x4 a, b;
    a.x = pk2(v[0], v[1]); a.y = pk2(v[2], v[3]); a.z = pk2(v[4], v[5]); a.w = pk2(v[6], v[7]);
    b.x = pk2(v[8], v[9]); b.y = pk2(v[10], v[11]); b.z = pk2(v[12], v[13]); b.w = pk2(v[14], v[15]);
    *(u32x4*)dst = a; *(u32x4*)(dst + 8) = b;
}
DI void store_T16(u16* base, const f32x16& v) {
#pragma unroll
    for (int i = 0; i < 16; ++i) base[(size_t)i * S_] = f2bf(v[i]);
}
DI float sumsq16(const f32x16& v) { float s = 0.f;
#pragma unroll
    for (int i = 0; i < 16; ++i) s += v[i] * v[i];
    return s; }


#define XB_TMO      128
#define XB_XCNT(j)  (256  + 64 * (j))
#define XB_XSUB(j)  (1280 + 64 * (j))
#define XB_XGEN(j)  (2304 + 64 * (j))
#define XB_TOP      3328
#define XB_TOPGEN   3392
#define XCD_BAR_WORDS 3456
#define XB_SPIN_CAP (1u << 18)
#define LAS __attribute__((address_space(3)))
DI unsigned xb_ld(unsigned* p) { return __hip_atomic_load(p, __ATOMIC_RELAXED, __HIP_MEMORY_SCOPE_AGENT); }
DI unsigned xb_add(unsigned* p, unsigned v) { return __hip_atomic_fetch_add(p, v, __ATOMIC_RELAXED, __HIP_MEMORY_SCOPE_AGENT); }
DI unsigned xb_xcc_id() { return (unsigned)__builtin_amdgcn_s_getreg((3 << 11) | 20) & 0xFu; }
#define XB_SPIN(cond, bar) do { unsigned _sp = 0; while (cond) { __builtin_amdgcn_s_sleep(1); \
    if ((++_sp & 255u) == 0u) { if (xb_ld(&(bar)[XB_TMO])) break; if (_sp > XB_SPIN_CAP) { atomicAdd(&(bar)[XB_TMO], 1u); break; } } } } while (0)
struct XcdBarrier { unsigned* bar; unsigned x; volatile LAS unsigned* st; };
DI XcdBarrier xcd_barrier_post(unsigned* bar, volatile LAS unsigned* st) {
    XcdBarrier b; b.bar = bar; b.x = xb_xcc_id(); b.st = st;
    if (threadIdx.x == 0) (void)xb_add(&bar[XB_XCNT(b.x)], 1u);
    return b;
}
DI void xcd_barrier_complete(unsigned* bar, unsigned x, unsigned& nloc, unsigned& nx) {
    const unsigned G = gridDim.x * gridDim.y * gridDim.z;
    unsigned sum, cnt, mine, sp = 0u;
    for (;;) {
        sum = 0u; cnt = 0u; mine = 0u;
#pragma unroll
        for (unsigned j = 0; j < 16; ++j) { const unsigned c = xb_ld(&bar[XB_XCNT(j)]); sum += c; cnt += (c > 0u) ? 1u : 0u; mine = (j == x) ? c : mine; }
        if (sum == G) break;
        __builtin_amdgcn_s_sleep(1);
        if ((++sp & 255u) == 0u) { if (xb_ld(&bar[XB_TMO])) break; if (sp > XB_SPIN_CAP) { atomicAdd(&bar[XB_TMO], 1u); break; } }
    }
    nloc = mine > 0u ? mine : 1u; nx = cnt > 0u ? cnt : 1u;
}
DI void xcd_barrier(const XcdBarrier& b) {
    asm volatile("s_waitcnt vmcnt(0)" ::: "memory");
    __syncthreads();
    if (threadIdx.x == 0) {
        unsigned* bar = b.bar;
        __builtin_amdgcn_s_waitcnt(0);
        unsigned nloc = b.st[0], nx = b.st[1];
        if (nloc == 0u) { xcd_barrier_complete(bar, b.x, nloc, nx); b.st[0] = nloc; b.st[1] = nx; }
        const unsigned old = xb_add(&bar[XB_XSUB(b.x)], 1u);
        const unsigned gen = old / nloc;
        if (old + 1u == (gen + 1u) * nloc) {
            __builtin_amdgcn_fence(__ATOMIC_RELEASE, "agent");
            asm volatile("s_waitcnt vmcnt(0)" ::: "memory");
            const unsigned og = xb_add(&bar[XB_TOP], 1u);
            const unsigned tg = og / nx;
            if (og + 1u == (tg + 1u) * nx) xb_add(&bar[XB_TOPGEN], 1u);
            else XB_SPIN(xb_ld(&bar[XB_TOPGEN]) == tg, bar);
            __builtin_amdgcn_fence(__ATOMIC_ACQUIRE, "agent");
            xb_add(&bar[XB_XGEN(b.x)], 1u);
            asm volatile("s_waitcnt vmcnt(0)" ::: "memory");
        } else {
            XB_SPIN(xb_ld(&bar[XB_XGEN(b.x)]) == gen, bar);
            __builtin_amdgcn_fence(__ATOMIC_ACQUIRE, "agent");
            asm volatile("s_waitcnt vmcnt(0)" ::: "memory");
        }
    }
    __syncthreads();
}

struct CJob { const float* src; const float* src2; const float* scale; u16* dst; int K, N, Npad, map; };
DI int srccol(int map, int n) {
    if (map == 0) return n;
    if (map == 1) { if (n < 640) return n; if (n < 2176) return n + 32; if (n < 2208) return n - 2176 + 640; return -1; }
    if (map == 2) { if (n < 1536) return n; if (n < 3584) return n + 8; if (n < 3592) return n - 3584 + 1536; return -1; }
    { const int j = n >> 6, w = n & 63; return (w < 32) ? (32 * j + w) : (32 * j + (w - 32) + (1 << 24)); }
}
DI CJob get_job(const Params& p, int id) {
    CJob j; j.src2 = nullptr; j.scale = nullptr; j.map = 0;
    unsigned char* ws = p.ws;
    switch (id) {
    case 0: j.src = p.in[4]; j.scale = p.in[1]; j.dst = (u16*)(ws + W_IN0); j.K = 1024; j.N = 2208; j.Npad = 2304; j.map = 1; break;
    case 1: j.src = p.in[6]; j.scale = p.in[5]; j.dst = (u16*)(ws + W_UQ); j.K = 384; j.N = 768; j.Npad = 768; break;
    case 2: j.src = p.in[8]; j.scale = p.in[7]; j.dst = (u16*)(ws + W_UKV); j.K = 256; j.N = 1024; j.Npad = 1024; break;
    case 3: j.src = p.in[14]; j.dst = (u16*)(ws + W_OUT0); j.K = 1024; j.N = 1024; j.Npad = 1024; break;
    case 4: j.src = p.in[25]; j.src2 = p.in[26]; j.scale = p.in[2]; j.dst = (u16*)(ws + W_GU0); j.K = 1024; j.N = 2816; j.Npad = 5632; j.map = 3; break;
    case 5: j.src = p.in[27]; j.dst = (u16*)(ws + W_D0); j.K = 2816; j.N = 1024; j.Npad = 1024; break;
    case 6: j.src = p.in[15]; j.scale = p.in[1] + 1024; j.dst = (u16*)(ws + W_IN1); j.K = 1024; j.N = 3592; j.Npad = 3840; j.map = 2; break;
    case 7: j.src = p.in[24]; j.dst = (u16*)(ws + W_OUT1); j.K = 1024; j.N = 1024; j.Npad = 1024; break;
    case 8: j.src = p.in[25] + (size_t)1024 * 2816; j.src2 = p.in[26] + (size_t)1024 * 2816; j.scale = p.in[2] + 1024; j.dst = (u16*)(ws + W_GU1); j.K = 1024; j.N = 2816; j.Npad = 5632; j.map = 3; break;
    default: j.src = p.in[27] + (size_t)2816 * 1024; j.dst = (u16*)(ws + W_D1); j.K = 2816; j.N = 1024; j.Npad = 1024; break;
    }
    return j;
}
DI int job_tiles(int id) {
    switch (id) {
    case 0: return 9 * 16;  case 1: return 3 * 6;   case 2: return 4 * 4;   case 3: return 4 * 16;  case 4: return 22 * 16;
    case 5: return 4 * 44;  case 6: return 15 * 16; case 7: return 4 * 16;  case 8: return 22 * 16; default: return 4 * 44;
    }
}
DI bool job_locate(int t, int j0, int j1, int& id, int& lt) {
    for (int j = j0; j < j1; ++j) { const int n = job_tiles(j); if (t < n) { id = j; lt = t; return true; } t -= n; }
    return false;
}
DI void convert_jobs(const Params& p, int j0, int j1, char* lds, const int dry) {
    float* tile = (float*)lds;
    const int tid = threadIdx.x;
    const int n4 = tid & 63, kk_r = tid >> 6;
    f32x4 cur[8];
    auto load_tile = [&](const CJob& j, int lt) {
        const int ntn = j.Npad / 256;
        const int tn = lt % ntn, tk = lt / ntn;
        int sc = srccol(j.map, tn * 256 + 4 * n4);
        const float* s = j.src;
        if (sc >= (1 << 24)) { sc -= (1 << 24); s = j.src2; }
#pragma unroll
        for (int i = 0; i < 8; ++i) {
            const int k = tk * 64 + kk_r + 8 * i;
            f32x4 v; v.x = v.y = v.z = v.w = 0.f;
            if (sc >= 0) { v = *(const f32x4*)(s + (size_t)k * j.N + sc); if (j.scale) { const float sk = j.scale[k]; v.x *= sk; v.y *= sk; v.z *= sk; v.w *= sk; } }
            cur[i] = v;
        }
    };
    int t = blockIdx.x, id, lt;
    bool have = job_locate(t, j0, j1, id, lt);
    if (have) load_tile(get_job(p, id), lt);
    while (have) {
        const CJob j = get_job(p, id);
        const int ntn = j.Npad / 256;
        const int n0 = (lt % ntn) * 256, k0 = (lt / ntn) * 64;
#pragma unroll
        for (int i = 0; i < 8; ++i) {
            float* d = tile + (kk_r + 8 * i) * 257 + 4 * n4;
            d[0] = cur[i].x; d[1] = cur[i].y; d[2] = cur[i].z; d[3] = cur[i].w;
        }
        __syncthreads();
        t += gridDim.x;
        have = job_locate(t, j0, j1, id, lt);
        if (have) load_tile(get_job(p, id), lt);
        {
            const int kp = tid & 31;
#pragma unroll 4
            for (int i = 0; i < 16; ++i) {
                const int nn = (tid >> 5) + 16 * i;
                const unsigned v = pk2(tile[(2 * kp) * 257 + nn], tile[(2 * kp + 1) * 257 + nn]);
                if (!dry) *(unsigned*)(j.dst + (size_t)(n0 + nn) * j.K + k0 + 2 * kp) = v;
            }
        }
        __syncthreads();
    }
}

DI void phase0(const Params& p, char* lds, const int dry) {
    const int tid = threadIdx.x;
    const int gtid = blockIdx.x * NTHR + tid, gsz = gridDim.x * NTHR;
    float* ssq = (float*)(p.ws + OFF_SSQ);
    unsigned* ctrl = (unsigned*)(p.ws + OFF_CTRL);
    if (gtid == 0) {
        float s1 = 0.f, s2 = 0.f;
        for (int i = 0; i < 64; ++i) { s1 += p.in[9][i] * p.in[10][i]; s2 += p.in[11][i] * p.in[12][i]; }
        if (!dry) ((float*)ctrl)[16] = expf(s1) - expf(s2) + 0.2f;
    }
    if (gtid < 512 && !dry) ((float*)ctrl)[64 + gtid] = 1.f / (1.f + expf(p.in[23][gtid] - p.in[23][512 + gtid]));
    f32x2* rd = (f32x2*)(p.ws + OFF_ROPED);
    for (int i = gtid; i < S_ * 32; i += gsz) {
        const int pos = i >> 5, d = i & 31;
        const float inv = 1.0f / powf(10000.0f, (float)(2 * d) / 64.0f);
        const float ang = (float)pos * inv;
        f32x2 cs; cs.x = cosf(ang); cs.y = sinf(ang); if (!dry) rd[i] = cs;
    }
    f32x2* rm = (f32x2*)(p.ws + OFF_ROPEM);
    for (int i = gtid; i < S_ * 16; i += gsz) {
        const int pos = i >> 4, d = i & 15;
        const float inv = 1.0f / powf(10000.0f, (float)(2 * d) / 32.0f);
        const float ang = (float)pos * inv;
        f32x2 cs; cs.x = cosf(ang); cs.y = sinf(ang); if (!dry) rm[i] = cs;
    }
    {
        const int lane = tid & 63, gw = gtid >> 6, nw = gsz >> 6;
        const float* x = p.in[0];
        u16* xb = (u16*)(p.ws + OFF_XB);
        for (int row0 = gw * 4; row0 < T_; row0 += nw * 4) {
            f32x4 v[4][4];
#pragma unroll
            for (int rr = 0; rr < 4; ++rr)
#pragma unroll
                for (int jj = 0; jj < 4; ++jj) v[rr][jj] = *(const f32x4*)(x + (size_t)(row0 + rr) * 1024 + jj * 256 + lane * 4);
#pragma unroll
            for (int rr = 0; rr < 4; ++rr) {
                float s = 0.f;
#pragma unroll
                for (int jj = 0; jj < 4; ++jj) {
                    const f32x4 q = v[rr][jj];
                    s += q.x * q.x + q.y * q.y + q.z * q.z + q.w * q.w;
                    u32x2 o; o.x = pk2(q.x, q.y); o.y = pk2(q.z, q.w);
                    if (!dry) *(u32x2*)(xb + (size_t)(row0 + rr) * 1024 + jj * 256 + lane * 4) = o;
                }
#pragma unroll
                for (int off = 32; off > 0; off >>= 1) s += __shfl_xor(s, off, 64);
                if (lane == 0 && !dry) ssq[row0 + rr] = s;
            }
        }
    }
    convert_jobs(p, 0, 8, lds, dry);
}

constexpr int LROW = 144;
constexpr int GEMM_LDS = 147456;

constexpr int DSTG = 32768;
#define RAW_BARRIER() do { asm volatile("s_waitcnt lgkmcnt(0)" ::: "memory"); __builtin_amdgcn_s_barrier(); } while (0)
DI void glds16(const char* g, char* l) { __builtin_amdgcn_global_load_lds((const unsigned*)g, (unsigned*)l, 16, 0, 0); }
template <int HALF, class Epi>
DI void gemm_tile(const u16* __restrict__ A, int lda, const u16* __restrict__ W, int ldw, int K, int m0, int n0, char* lds, Epi&& epi) {
    constexpr int MT = HALF ? 2 : 4;
    constexpr int NI = HALF ? 3 : 4;
    int tid = threadIdx.x;
    asm volatile("" : "+v"(tid));
    const int wave = tid >> 6, lane = tid & 63, r = lane & 31, h = lane >> 5;
    const int wm = HALF ? (wave >> 1) : (wave >> 2), wn = HALF ? (wave & 1) : (wave & 3);
    f32x16 acc[MT][2];
#pragma unroll
    for (int mt = 0; mt < MT; ++mt) { acc[mt][0] = zero16(); acc[mt][1] = zero16(); }
    const int drow = lane >> 2, dchunk = (lane & 3) ^ ((drow >> 2) & 3);
    const char* asrc = (const char*)(A + (size_t)(m0 + 32 * wave + drow) * lda) + dchunk * 16;
    const char* wsrc = (const char*)(W + (size_t)(n0 + (HALF ? 16 : 32) * wave + drow) * ldw) + dchunk * 16;
    const size_t a16 = (size_t)lda * 32, w16 = (size_t)ldw * 32;
    char* dbase = lds + wave * 2048;
    char* wbase = lds + 16384 + wave * (HALF ? 1024 : 2048);
    const int nk = K >> 5;
    RAW_BARRIER();
#define GEMM_ISSUE(kt_) do { const int so_ = ((kt_) & 3) * DSTG; const int ko_ = (kt_) * 64; \
        glds16(asrc + ko_, dbase + so_); glds16(asrc + a16 + ko_, dbase + so_ + 1024); glds16(wsrc + ko_, wbase + so_); if (!HALF) glds16(wsrc + w16 + ko_, wbase + so_ + 1024); } while (0)
#define GEMM_WAIT(n_) do { if ((n_) >= 2) { if (HALF) asm volatile("s_waitcnt vmcnt(6)" ::: "memory"); else asm volatile("s_waitcnt vmcnt(8)" ::: "memory"); } \
        else if ((n_) == 1) { if (HALF) asm volatile("s_waitcnt vmcnt(3)" ::: "memory"); else asm volatile("s_waitcnt vmcnt(4)" ::: "memory"); } \
        else asm volatile("s_waitcnt vmcnt(0)" ::: "memory"); } while (0)
    GEMM_ISSUE(0);
    if (nk > 1) GEMM_ISSUE(1);
    if (nk > 2) GEMM_ISSUE(2);
    const int a_rd = (wm * (HALF ? 64 : 128) + r) * 64, a_sw = (r >> 2) & 3;
    const int w_rd = 16384 + (wn * 64 + perm32(r)) * 64, w_sw = r >> 3;
    GEMM_WAIT(nk > 2 ? 2 : (nk > 1 ? 1 : 0));
    RAW_BARRIER();
    bf16x8 fa[MT], fw[2];
#pragma unroll
    for (int mt = 0; mt < MT; ++mt) fa[mt] = *(const bf16x8*)(lds + a_rd + mt * 2048 + ((h ^ a_sw) << 4));
    fw[0] = *(const bf16x8*)(lds + w_rd + ((h ^ w_sw) << 4));
    fw[1] = *(const bf16x8*)(lds + w_rd + 2048 + ((h ^ w_sw) << 4));
    for (int kt = 0; kt < nk; ++kt) {
        if (kt + 3 < nk) GEMM_ISSUE(kt + 3);
        const char* buf = lds + (kt & 3) * DSTG;
        bf16x8 ga[MT], gw[2];
#pragma unroll
        for (int mt = 0; mt < MT; ++mt) ga[mt] = *(const bf16x8*)(buf + a_rd + mt * 2048 + (((2 + h) ^ a_sw) << 4));
        gw[0] = *(const bf16x8*)(buf + w_rd + (((2 + h) ^ w_sw) << 4));
        gw[1] = *(const bf16x8*)(buf + w_rd + 2048 + (((2 + h) ^ w_sw) << 4));
#pragma unroll
        for (int mt = 0; mt < MT; ++mt) {
            acc[mt][0] = MFMA32(fw[0], fa[mt], acc[mt][0]);
            acc[mt][1] = MFMA32(fw[1], fa[mt], acc[mt][1]);
        }
        const int rem = nk - 1 - kt;
        if (rem >= 1) {
            GEMM_WAIT(rem >= 3 ? 2 : rem - 1);
            RAW_BARRIER();
            const char* nb = lds + ((kt + 1) & 3) * DSTG;
#pragma unroll
            for (int mt = 0; mt < MT; ++mt) fa[mt] = *(const bf16x8*)(nb + a_rd + mt * 2048 + ((h ^ a_sw) << 4));
            fw[0] = *(const bf16x8*)(nb + w_rd + ((h ^ w_sw) << 4));
            fw[1] = *(const bf16x8*)(nb + w_rd + 2048 + ((h ^ w_sw) << 4));
        }
#pragma unroll
        for (int mt = 0; mt < MT; ++mt) {
            acc[mt][0] = MFMA32(gw[0], ga[mt], acc[mt][0]);
            acc[mt][1] = MFMA32(gw[1], ga[mt], acc[mt][1]);
        }
    }
#undef GEMM_ISSUE
#undef GEMM_WAIT
    const int colbase = n0 + wn * 64;
#pragma unroll
    for (int mt = 0; mt < MT; ++mt) epi(m0 + wm * (HALF ? 64 : 128) + mt * 32 + r, colbase, acc[mt][0], acc[mt][1]);
}

DI bool tile_map(int round, int NT, int& mi, int& ni, int& half) {
    const int x = blockIdx.x & 7, l = blockIdx.x >> 3, nl = gridDim.x >> 3;
    const int q = l + nl * round;
    const int F = 8 * NT, full = (F / nl) * nl;
    int t;
    if (q < full) { t = q; half = -1; }
    else {
        const int qh = q - full;
        if (qh >= 2 * (F - full)) return false;
        t = full + (qh >> 1); half = qh & 1;
    }
    const int ng = t >> 5, idx = t & 31;
    mi = 8 * x + (idx & 7);
    ni = 4 * ng + (idx >> 3);
    return true;
}
#define GEMM_DISPATCH(A_, lda_, W_, ldw_, K_, mi_, ncol0_, half_, epi_) do { \
        if ((half_) < 0) gemm_tile<0>(A_, lda_, W_, ldw_, K_, (mi_) * 256, (ncol0_), lds, epi_); \
        else gemm_tile<1>(A_, lda_, W_, ldw_, K_, (mi_) * 256, (ncol0_) + 128 * (half_), lds, epi_); } while (0)

DI void scale16(f32x16& v, float s) {
#pragma unroll
    for (int i = 0; i < 16; ++i) v[i] *= s;
}
DI void rope32(f32x16& v, const f32x2* tab, int h) {
#pragma unroll
    for (int i = 0; i < 16; ++i) {
        const float o = xor32(v[i]);
        const f32x2 cs = tab[i];
        v[i] = (h == 0) ? (v[i] * cs.x - o * cs.y) : (v[i] * cs.x + o * cs.y);
    }
}
DI void rope64(f32x16& c0, f32x16& c1, const f32x2* tab, int h) {
#pragma unroll
    for (int i = 0; i < 16; ++i) {
        const f32x2 cs = tab[16 * h + i];
        const float x1 = c0[i], x2 = c1[i];
        c0[i] = x1 * cs.x - x2 * cs.y;
        c1[i] = x2 * cs.x + x1 * cs.y;
    }
}
DI void ssq_put(float* slot, float part, int h) {
    part += xor32(part);
    if (h == 0) *slot = part;
}
DI float ssq_get16(const float* row16) {
    const f32x4 a = *(const f32x4*)row16, b = *(const f32x4*)(row16 + 4), c = *(const f32x4*)(row16 + 8), d = *(const f32x4*)(row16 + 12);
    return ((a.x + a.y) + (a.z + a.w)) + ((b.x + b.y) + (b.z + b.w)) + (((c.x + c.y) + (c.z + c.w)) + ((d.x + d.y) + (d.z + d.w)));
}

DI void phase_inproj0(const Params& p, char* lds, const int dry) {
    unsigned char* ws = p.ws;
    const u16* A = (const u16*)(ws + OFF_XB);
    const u16* W = (const u16*)(ws + W_IN0);
    const float* ssq0 = (const float*)(ws + OFF_SSQ);
    float* ssq_q = (float*)(ws + SSQP_Q);
    float* ssq_kv = (float*)(ws + SSQP_KV);
    const f32x2* ropeD = (const f32x2*)(ws + OFF_ROPED);
    const f32x2* ropeM = (const f32x2*)(ws + OFF_ROPEM);
    const int h = (threadIdx.x & 63) >> 5;
    auto epi = [&](int row, int cb, f32x16& c0, f32x16& c1) {
        if (dry) return;
        const float rs = rsqrtf(ssq0[row] * (1.f / 1024.f) + EPS);
        scale16(c0, rs); scale16(c1, rs);
        const int pos = row & (S_ - 1), b = row >> 12;
        if (cb < 384) {
            u16* d = (u16*)(ws + R_CQ) + (size_t)row * 384 + cb + 16 * h;
            store_bf16x16(d, c0); store_bf16x16(d + 32, c1);
            ssq_put(ssq_q + (size_t)row * 8 + (cb >> 6), sumsq16(c0) + sumsq16(c1), h);
        } else if (cb < 640) {
            u16* d = (u16*)(ws + R_CKV) + (size_t)row * 256 + (cb - 384) + 16 * h;
            store_bf16x16(d, c0); store_bf16x16(d + 32, c1);
            ssq_put(ssq_kv + (size_t)row * 4 + ((cb - 384) >> 6), sumsq16(c0) + sumsq16(c1), h);
        } else if (cb < 1152) {
            rope64(c0, c1, ropeD + (size_t)pos * 32, h);
            scale16(c0, 0.125f * LOG2E); scale16(c1, 0.125f * LOG2E);
            u16* d = (u16*)(ws + R_DQ) + (size_t)row * 512 + (cb - 640) + 16 * h;
            store_bf16x16(d, c0); store_bf16x16(d + 32, c1);
        } else if (cb < 1664) {
            rope64(c0, c1, ropeD + (size_t)pos * 32, h);
            u16* d = (u16*)(ws + R_DK) + (size_t)row * 512 + (cb - 1152) + 16 * h;
            store_bf16x16(d, c0); store_bf16x16(d + 32, c1);
        } else if (cb < 2176) {
            u16* d = (u16*)(ws + R_DVT) + ((size_t)b * 512 + (cb - 1664) + 16 * h) * S_ + pos;
            store_T16(d, c0); store_T16(d + (size_t)32 * S_, c1);
        } else if (cb == 2176) {
            rope32(c0, ropeM + (size_t)pos * 16, h);
            store_bf16x16((u16*)(ws + R_KR) + (size_t)row * 32 + 16 * h, c0);
        }
    };
    constexpr int NT = 9;
    { int mi, ni, hf; for (int rd = 0; tile_map(rd, NT, mi, ni, hf); ++rd) GEMM_DISPATCH(A, 1024, W, 1024, 1024, mi, ni * 256, hf, epi); }
}

DI void phase_upproj0(const Params& p, char* lds, const int dry) {
    unsigned char* ws = p.ws;
    const float* ssq_q = (const float*)(ws + SSQP_Q);
    const float* ssq_kv = (const float*)(ws + SSQP_KV);
    const f32x2* ropeM = (const f32x2*)(ws + OFF_ROPEM);
    const int h = (threadIdx.x & 63) >> 5;
    auto epi_q = [&](int row, int cb, f32x16& c0, f32x16& c1) {
        if (dry) return;
        const f32x4 qa = *(const f32x4*)(ssq_q + (size_t)row * 8); const f32x2 qb = *(const f32x2*)(ssq_q + (size_t)row * 8 + 4);
        const float rs = rsqrtf((((qa.x + qa.y) + (qa.z + qa.w)) + (qb.x + qb.y)) * (1.f / 384.f) + EPS) * (0.10206207261596575f * LOG2E);
        scale16(c0, rs); scale16(c1, rs);
        const int pos = row & (S_ - 1);
        const int blk = cb >> 5;
        if (blk % 3 == 2) rope32(c0, ropeM + (size_t)pos * 16, h);
        if ((blk + 1) % 3 == 2) rope32(c1, ropeM + (size_t)pos * 16, h);
        u16* d = (u16*)(ws + R_QM) + (size_t)row * 768 + cb + 16 * h;
        store_bf16x16(d, c0); store_bf16x16(d + 32, c1);
    };
    auto epi_kv = [&](int row, int cb, f32x16& c0, f32x16& c1) {
        if (dry) return;
        const f32x4 ka = *(const f32x4*)(ssq_kv + (size_t)row * 4);
        const float rs = rsqrtf(((ka.x + ka.y) + (ka.z + ka.w)) * (1.f / 256.f) + EPS);
        scale16(c0, rs); scale16(c1, rs);
        const int pos = row & (S_ - 1), b = row >> 12;
        const int head = cb >> 7;
        if ((cb & 64) == 0) {
            u16* d = (u16*)(ws + R_KN) + (size_t)row * 512 + head * 64 + 16 * h;
            store_bf16x16(d, c0); store_bf16x16(d + 32, c1);
        } else {
            u16* d = (u16*)(ws + R_VMT) + ((size_t)b * 512 + head * 64 + 16 * h) * S_ + pos;
            store_T16(d, c0); store_T16(d + (size_t)32 * S_, c1);
        }
    };
    int mi, ni, hf;
    for (int rd = 0; tile_map(rd, 7, mi, ni, hf); ++rd) {
        if (ni < 3) GEMM_DISPATCH((const u16*)(ws + R_CQ), 384, (const u16*)(ws + W_UQ), 384, 384, mi, ni * 256, hf, epi_q);
        else GEMM_DISPATCH((const u16*)(ws + R_CKV), 256, (const u16*)(ws + W_UKV), 256, 256, mi, (ni - 3) * 256, hf, epi_kv);
    }
}

DI void phase_resid(const Params& p, char* lds, const u16* A, int K, const u16* W, float* ssq_out, const int dry) {
    unsigned char* ws = p.ws;
    const int h = (threadIdx.x & 63) >> 5;
    auto epi = [&](int row, int cb, f32x16& c0, f32x16& c1) {
        if (dry) return;
        u16* d = (u16*)(ws + OFF_XB) + (size_t)row * 1024 + cb + 16 * h;
        const u32x4 r0a = *(const u32x4*)d, r0b = *(const u32x4*)(d + 8), r1a = *(const u32x4*)(d + 32), r1b = *(const u32x4*)(d + 40);
        c0[0] += bflo(r0a.x); c0[1] += bfhi(r0a.x); c0[2] += bflo(r0a.y); c0[3] += bfhi(r0a.y); c0[4] += bflo(r0a.z); c0[5] += bfhi(r0a.z); c0[6] += bflo(r0a.w); c0[7] += bfhi(r0a.w);
        c0[8] += bflo(r0b.x); c0[9] += bfhi(r0b.x); c0[10] += bflo(r0b.y); c0[11] += bfhi(r0b.y); c0[12] += bflo(r0b.z); c0[13] += bfhi(r0b.z); c0[14] += bflo(r0b.w); c0[15] += bfhi(r0b.w);
        c1[0] += bflo(r1a.x); c1[1] += bfhi(r1a.x); c1[2] += bflo(r1a.y); c1[3] += bfhi(r1a.y); c1[4] += bflo(r1a.z); c1[5] += bfhi(r1a.z); c1[6] += bflo(r1a.w); c1[7] += bfhi(r1a.w);
        c1[8] += bflo(r1b.x); c1[9] += bfhi(r1b.x); c1[10] += bflo(r1b.y); c1[11] += bfhi(r1b.y); c1[12] += bflo(r1b.z); c1[13] += bfhi(r1b.z); c1[14] += bflo(r1b.w); c1[15] += bfhi(r1b.w);
        store_bf16x16(d, c0); store_bf16x16(d + 32, c1);
        ssq_put(ssq_out + (size_t)row * 16 + (cb >> 6), sumsq16(c0) + sumsq16(c1), h);
    };
    { int mi, ni, hf; for (int rd = 0; tile_map(rd, 4, mi, ni, hf); ++rd) GEMM_DISPATCH(A, K, W, K, K, mi, ni * 256, hf, epi); }
}

DI void phase_ffn_up(const Params& p, char* lds, const u16* W, const float* ssq, const int dry) {
    unsigned char* ws = p.ws;
    const int h = (threadIdx.x & 63) >> 5;
    auto epi = [&](int row, int cb, f32x16& c0, f32x16& c1) {
        if (dry) return;
        const float rs = rsqrtf(ssq_get16(ssq + (size_t)row * 16) * (1.f / 1024.f) + EPS);
        f32x16 hv;
#pragma unroll
        for (int i = 0; i < 8; ++i) {
            f32x2 g, u; g.x = c0[2 * i]; g.y = c0[2 * i + 1]; u.x = c1[2 * i]; u.y = c1[2 * i + 1];
            g = g * rs; u = u * rs;
            const f32x2 t = g * (-LOG2E);
            f32x2 e; e.x = __builtin_amdgcn_exp2f(t.x); e.y = __builtin_amdgcn_exp2f(t.y);
            e = e + 1.0f;
            f32x2 rr; rr.x = __builtin_amdgcn_rcpf(e.x); rr.y = __builtin_amdgcn_rcpf(e.y);
            const f32x2 hh = (g * u) * rr;
            hv[2 * i] = hh.x; hv[2 * i + 1] = hh.y;
        }
        store_bf16x16((u16*)(ws + R_H) + (size_t)row * 2816 + (cb >> 1) + 16 * h, hv);
    };
    constexpr int NT = 22;
    { int mi, ni, hf; for (int rd = 0; tile_map(rd, NT, mi, ni, hf); ++rd) GEMM_DISPATCH((const u16*)(ws + OFF_XB), 1024, W, 1024, 1024, mi, ni * 256, hf, epi); }
}

template <bool MLA>
DI void attn_pass(const u16* __restrict__ qbase, int qld, const u16* __restrict__ kbase, int kld, const u16* __restrict__ krbase,
                  const u16* __restrict__ vtbase, int q0, char* lds, f32x16 (&o)[MLA ? 2 : 4], float& linv) {
    constexpr int DKD = MLA ? 96 : 64, DVD = MLA ? 64 : 128, NKS = DKD / 16, NVT = DVD / 32, CPR = DKD / 8, NKC = (64 * CPR + NTHR - 1) / NTHR, NVC = DVD * 8 / NTHR;
    constexpr int KSTR = DKD * 2 + 16, BUF = 64 * KSTR + DVD * LROW;
    int tid = threadIdx.x;
    asm volatile("" : "+v"(tid));
    const int wave = tid >> 6, lane = tid & 63, r = lane & 31, h = lane >> 5;
    const int qw0 = q0 + 32 * wave;
    bf16x8 qf[NKS];
#pragma unroll
    for (int ks = 0; ks < NKS; ++ks) qf[ks] = *(const bf16x8*)(qbase + (size_t)(qw0 + r) * qld + ks * 16 + h * 8);
    float m = -INFINITY, l = 0.f;
#pragma unroll
    for (int vt = 0; vt < NVT; ++vt) o[vt] = zero16();
    const int ntiles = (q0 >> 6) + 4;
    u32x4 rk[NKC], rv[NVC];
#pragma unroll
    for (int i = 0; i < NKC; ++i) {
        const int c = tid + NTHR * i, row = c / CPR, cc = c % CPR;
        if (c < 64 * CPR) {
            if (MLA && cc >= 8) rk[i] = *(const u32x4*)(krbase + (size_t)row * 32 + (cc - 8) * 8);
            else rk[i] = *(const u32x4*)(kbase + (size_t)row * kld + cc * 8);
        }
    }
#pragma unroll
    for (int i = 0; i < NVC; ++i) { const int c = tid + NTHR * i, row = c >> 3, cc = c & 7; rv[i] = *(const u32x4*)(vtbase + (size_t)row * S_ + cc * 8); }
#pragma unroll
    for (int i = 0; i < NKC; ++i) { const int c = tid + NTHR * i, row = c / CPR, cc = c % CPR; if (c < 64 * CPR) *(u32x4*)(lds + row * KSTR + cc * 16) = rk[i]; }
#pragma unroll
    for (int i = 0; i < NVC; ++i) { const int c = tid + NTHR * i, row = c >> 3, cc = c & 7; char* d_ = lds + 64 * KSTR + row * LROW + (cc >> 1) * 32 + (cc & 1) * 8; u32x2 a_, b_; a_.x = rv[i].x; a_.y = rv[i].y; b_.x = rv[i].z; b_.y = rv[i].w; *(u32x2*)d_ = a_; *(u32x2*)(d_ + 16) = b_; }
    __syncthreads();
    for (int kt = 0; kt < ntiles; ++kt) {
        const char* buf = lds + (kt & 1) * BUF;
        if (kt + 1 < ntiles) {
            const int kb = (kt + 1) * 64;
#pragma unroll
            for (int i = 0; i < NKC; ++i) {
                const int c = tid + NTHR * i, row = c / CPR, cc = c % CPR;
                if (c < 64 * CPR) {
                    if (MLA && cc >= 8) rk[i] = *(const u32x4*)(krbase + (size_t)(kb + row) * 32 + (cc - 8) * 8);
                    else rk[i] = *(const u32x4*)(kbase + (size_t)(kb + row) * kld + cc * 8);
                }
            }
#pragma unroll
            for (int i = 0; i < NVC; ++i) { const int c = tid + NTHR * i, row = c >> 3, cc = c & 7; rv[i] = *(const u32x4*)(vtbase + (size_t)row * S_ + kb + cc * 8); }
        }
        __builtin_amdgcn_sched_barrier(0);
        if (64 * kt <= qw0 + 31) {
            f32x16 s0 = zero16(), s1 = zero16();
            {
                bf16x8 kf0[NKS], kf1[NKS];
#pragma unroll
                for (int ks = 0; ks < NKS; ++ks) {
                    kf0[ks] = *(const bf16x8*)(buf + r * KSTR + ks * 32 + h * 16);
                    kf1[ks] = *(const bf16x8*)(buf + (32 + r) * KSTR + ks * 32 + h * 16);
                }
                __builtin_amdgcn_sched_barrier(0);
                __builtin_amdgcn_s_setprio(1);
#pragma unroll
                for (int ks = 0; ks < NKS; ++ks) {
                    s0 = MFMA32(kf0[ks], qf[ks], s0);
                    s1 = MFMA32(kf1[ks], qf[ks], s1);
                }
                __builtin_amdgcn_s_setprio(0);
            }
            const char* vb = buf + 64 * KSTR + r * LROW + h * 16;
            u32x4 va[NVT][2];
#pragma unroll
            for (int vt = 0; vt < NVT; ++vt)
#pragma unroll
                for (int ms = 0; ms < 2; ++ms) {
                    va[vt][ms] = *(const u32x4*)(vb + vt * 32 * LROW + ms * 32);
                }
            __builtin_amdgcn_sched_barrier(0);
            if (64 * kt + 63 > qw0) {
                const int q = qw0 + r;
#pragma unroll
                for (int i = 0; i < 16; ++i) {
                    const int key = 64 * kt + crow(i, h);
                    if (key > q) s0[i] = -INFINITY;
                    if (key + 32 > q) s1[i] = -INFINITY;
                }
            }
            float mx = s0[0];
#pragma unroll
            for (int i = 1; i < 16; ++i) mx = fmaxf(mx, s0[i]);
#pragma unroll
            for (int i = 0; i < 16; ++i) mx = fmaxf(mx, s1[i]);
            if (__builtin_amdgcn_ballot_w64(mx - m > 8.0f) != 0ull) {
                mx = fmaxf(mx, xor32(mx));
                const float mn = fmaxf(m, mx);
                const float alpha = __builtin_amdgcn_exp2f(m - mn);
                m = mn;
                l *= alpha;
#pragma unroll
                for (int vt = 0; vt < NVT; ++vt) scale16(o[vt], alpha);
            }
            const float mn = m;
            float ps = 0.f;
#pragma unroll
            for (int i = 0; i < 8; ++i) {
                f32x2 nm; nm.x = -mn; nm.y = -mn;
                f32x2 a; a.x = s0[2 * i]; a.y = s0[2 * i + 1];
                f32x2 b; b.x = s1[2 * i]; b.y = s1[2 * i + 1];
                a = a + nm; b = b + nm;
                s0[2 * i] = __builtin_amdgcn_exp2f(a.x); s0[2 * i + 1] = __builtin_amdgcn_exp2f(a.y);
                s1[2 * i] = __builtin_amdgcn_exp2f(b.x); s1[2 * i + 1] = __builtin_amdgcn_exp2f(b.y);
                ps += (s0[2 * i] + s1[2 * i]) + (s0[2 * i + 1] + s1[2 * i + 1]);
            }
            l += ps;
            const bf16x8 p00 = pack8(s0[0], s0[1], s0[2], s0[3], s0[4], s0[5], s0[6], s0[7]);
            const bf16x8 p01 = pack8(s0[8], s0[9], s0[10], s0[11], s0[12], s0[13], s0[14], s0[15]);
            const bf16x8 p10 = pack8(s1[0], s1[1], s1[2], s1[3], s1[4], s1[5], s1[6], s1[7]);
            const bf16x8 p11 = pack8(s1[8], s1[9], s1[10], s1[11], s1[12], s1[13], s1[14], s1[15]);
            u32x4 vc[NVT][2];
#pragma unroll
            for (int vt = 0; vt < NVT; ++vt)
#pragma unroll
                for (int ms = 2; ms < 4; ++ms) {
                    vc[vt][ms - 2] = *(const u32x4*)(vb + vt * 32 * LROW + ms * 32);
                }
            __builtin_amdgcn_sched_barrier(0);
            __builtin_amdgcn_s_setprio(1);
#pragma unroll
            for (int ms = 0; ms < 2; ++ms)
#pragma unroll
                for (int vt = 0; vt < NVT; ++vt) o[vt] = MFMA32(__builtin_bit_cast(bf16x8, va[vt][ms]), ms ? p01 : p00, o[vt]);
#pragma unroll
            for (int ms = 0; ms < 2; ++ms)
#pragma unroll
                for (int vt = 0; vt < NVT; ++vt) o[vt] = MFMA32(__builtin_bit_cast(bf16x8, vc[vt][ms]), ms ? p11 : p10, o[vt]);
            __builtin_amdgcn_s_setprio(0);
        }
        __builtin_amdgcn_sched_barrier(0);
        if (kt + 1 < ntiles) {
            char* nb = lds + ((kt + 1) & 1) * BUF;
#pragma unroll
            for (int i = 0; i < NKC; ++i) { const int c = tid + NTHR * i, row = c / CPR, cc = c % CPR; if (c < 64 * CPR) *(u32x4*)(nb + row * KSTR + cc * 16) = rk[i]; }
#pragma unroll
            for (int i = 0; i < NVC; ++i) { const int c = tid + NTHR * i, row = c >> 3, cc = c & 7; char* d_ = nb + 64 * KSTR + row * LROW + (cc >> 1) * 32 + (cc & 1) * 8; u32x2 a_, b_; a_.x = rv[i].x; a_.y = rv[i].y; b_.x = rv[i].z; b_.y = rv[i].w; *(u32x2*)d_ = a_; *(u32x2*)(d_ + 16) = b_; }
        }
        __syncthreads();
    }
    l += xor32(l);
    linv = 1.f / l;
}

DI void phase_attn(const Params& p, char* lds, int* s_item, const int dry) {
    unsigned char* ws = p.ws;
    const int tid = threadIdx.x, wave = tid >> 6, lane = tid & 63, r = lane & 31, h = lane >> 5;
    unsigned* ctrl = (unsigned*)(ws + OFF_CTRL);
    const float lam = ((const float*)ctrl)[16];
    const float* subln = p.in[13];
    for (;;) {
        if (tid == 0) *s_item = (int)atomicAdd(&ctrl[dry ? 1 : 0], 1u);
        __syncthreads();
        const int item = *s_item;
        __syncthreads();
        if (item >= 768) break;
        if (item < 256) {
            const int qb = 15 - (item >> 4), b = (item >> 2) & 3, head = item & 3;
            const int q0 = qb * 256;
            const size_t tb = (size_t)b * S_;
            const u16* vt = (const u16*)(ws + R_DVT) + ((size_t)b * 512 + head * 128) * S_;
            f32x16 o[4]; float linv;
            attn_pass<false>((const u16*)(ws + R_DQ) + tb * 512 + head * 128 + 64, 512, (const u16*)(ws + R_DK) + tb * 512 + head * 128 + 64, 512, nullptr, vt, q0, lds, o, linv);
            const size_t t = tb + q0 + 32 * wave + r;
            u16* dst = (u16*)(ws + R_MIX0) + t * 1024 + 512 + head * 128;
#pragma unroll
            for (int v = 0; v < 4; ++v)
#pragma unroll
                for (int g = 0; g < 4; ++g) {
                    const int dv = v * 32 + 8 * g + 4 * h;
                    u32x2 st; st.x = pk2(o[v][4 * g] * linv, o[v][4 * g + 1] * linv); st.y = pk2(o[v][4 * g + 2] * linv, o[v][4 * g + 3] * linv);
                    if (!dry) *(u32x2*)(dst + dv) = st;
                }
            attn_pass<false>((const u16*)(ws + R_DQ) + tb * 512 + head * 128, 512, (const u16*)(ws + R_DK) + tb * 512 + head * 128, 512, nullptr, vt, q0, lds, o, linv);
            float ss = 0.f;
#pragma unroll
            for (int v = 0; v < 4; ++v)
#pragma unroll
                for (int g = 0; g < 4; ++g) {
                    const int dv = v * 32 + 8 * g + 4 * h;
                    const u32x2 o1 = *(const u32x2*)(dst + dv);
                    const float a0 = o[v][4 * g] * linv - lam * bflo(o1.x), a1 = o[v][4 * g + 1] * linv - lam * bfhi(o1.x);
                    const float a2 = o[v][4 * g + 2] * linv - lam * bflo(o1.y), a3 = o[v][4 * g + 3] * linv - lam * bfhi(o1.y);
                    o[v][4 * g] = a0; o[v][4 * g + 1] = a1; o[v][4 * g + 2] = a2; o[v][4 * g + 3] = a3;
                    ss += a0 * a0 + a1 * a1 + a2 * a2 + a3 * a3;
                }
            ss += xor32(ss);
            const float rs = rsqrtf(ss * (1.f / 128.f) + EPS) * 0.8f;
#pragma unroll
            for (int v = 0; v < 4; ++v)
#pragma unroll
                for (int g = 0; g < 4; ++g) {
                    const int dv = v * 32 + 8 * g + 4 * h;
                    const f32x4 w = *(const f32x4*)(subln + dv);
                    u32x2 st; st.x = pk2(o[v][4 * g] * rs * w.x, o[v][4 * g + 1] * rs * w.y); st.y = pk2(o[v][4 * g + 2] * rs * w.z, o[v][4 * g + 3] * rs * w.w);
                    if (!dry) *(u32x2*)(dst + dv) = st;
                }
        } else {
            const int j = item - 256;
            const int qb = 15 - (j >> 5), b = (j >> 3) & 3, head = j & 7;
            const int q0 = qb * 256;
            const size_t tb = (size_t)b * S_;
            f32x16 o[2]; float linv;
            attn_pass<true>((const u16*)(ws + R_QM) + tb * 768 + head * 96, 768, (const u16*)(ws + R_KN) + tb * 512 + head * 64, 512, (const u16*)(ws + R_KR) + tb * 32,
                            (const u16*)(ws + R_VMT) + ((size_t)b * 512 + head * 64) * S_, q0, lds, o, linv);
            const size_t t = tb + q0 + 32 * wave + r;
            u16* dst = (u16*)(ws + R_MIX0) + t * 1024 + head * 64;
#pragma unroll
            for (int v = 0; v < 2; ++v)
#pragma unroll
                for (int g = 0; g < 4; ++g) {
                    const int dv = v * 32 + 8 * g + 4 * h;
                    u32x2 st; st.x = pk2(o[v][4 * g] * linv, o[v][4 * g + 1] * linv); st.y = pk2(o[v][4 * g + 2] * linv, o[v][4 * g + 3] * linv);
                    if (!dry) *(u32x2*)(dst + dv) = st;
                }
        }
    }
}


DI void phase_inproj1(const Params& p, char* lds, const int dry) {
    unsigned char* ws = p.ws;
    const float* ssq = (const float*)(ws + SSQP_R) + (size_t)1 * T_ * 16;
    const float* lbt = (const float*)(ws + OFF_CTRL) + 64;
    const float* dt_bias = p.in[18];
    const int h = (threadIdx.x & 63) >> 5;
    auto epi = [&](int row, int cb, f32x16& c0, f32x16& c1) {
        if (dry) return;
        const float rs = rsqrtf(ssq_get16(ssq + (size_t)row * 16) * (1.f / 1024.f) + EPS);
        scale16(c0, rs); scale16(c1, rs);
        const int pos = row & (S_ - 1), b = row >> 12;
        if (cb < 512) {
#pragma unroll
            for (int i = 0; i < 16; ++i) { c0[i] = silu_f(c0[i]); c1[i] = silu_f(c1[i]); }
            u16* d = (u16*)(ws + R_ZS) + (size_t)row * 512 + cb + 16 * h;
            store_bf16x16(d, c0); store_bf16x16(d + 32, c1);
        } else if (cb < 1024) {
            u16* d = (u16*)(ws + R_XTRAW) + ((size_t)b * 512 + (cb - 512) + 16 * h) * S_ + pos;
            store_T16(d, c0); store_T16(d + (size_t)32 * S_, c1);
        } else if (cb < 1536) {
            u16* d = (u16*)(ws + R_BCRAW) + (size_t)row * 512 + (cb - 1024) + 16 * h;
            store_bf16x16(d, c0); store_bf16x16(d + 32, c1);
            if (cb < 1280) {
                u16* dT = (u16*)(ws + A_BTRAW) + ((size_t)b * 256 + (cb - 1024) + 16 * h) * S_ + pos;
                store_T16(dT, c0); store_T16(dT + (size_t)32 * S_, c1);
            }
        } else if (cb < 2048) {
#pragma unroll
            for (int i = 0; i < 16; ++i) { c0[i] = silu_f(c0[i]); c1[i] = silu_f(c1[i]); }
            u16* d = (u16*)(ws + R_HQT) + ((size_t)b * 512 + (cb - 1536) + 16 * h) * S_ + pos;
            store_T16(d, c0); store_T16(d + (size_t)32 * S_, c1);
        } else if (cb < 2560) {
            const int k0 = cb - 2048 + 16 * h;
            float* lf = (float*)(ws + R_LFT) + ((size_t)b * 512 + k0) * S_ + pos;
            u16* kt = (u16*)(ws + R_HKT) + ((size_t)b * 512 + k0) * S_ + pos;
#pragma unroll
            for (int half = 0; half < 2; ++half)
#pragma unroll
                for (int i = 0; i < 16; ++i) {
                    const int k = k0 + 32 * half + i;
                    const float lb = lbt[k];
                    const float x = half ? c1[i] : c0[i];
                    const float e = __expf(-x);
                    const float rcp = __builtin_amdgcn_rcpf(1.f + e);
                    const float f = lb + (1.f - lb) * rcp;
                    lf[(size_t)(32 * half + i) * S_] = __logf(f);
                    kt[(size_t)(32 * half + i) * S_] = f2bf((1.f - lb) * (e < 3.0e38f ? e * rcp : 1.f));
                }
        } else if (cb < 3072) {
            u16* d = (u16*)(ws + R_HVT) + ((size_t)b * 512 + (cb - 2560) + 16 * h) * S_ + pos;
            store_T16(d, c0); store_T16(d + (size_t)32 * S_, c1);
        } else if (cb < 3584) {
#pragma unroll
            for (int i = 0; i < 16; ++i) { c0[i] = silu_f(c0[i]); c1[i] = silu_f(c1[i]); }
            u16* d = (u16*)(ws + R_HG) + (size_t)row * 512 + (cb - 3072) + 16 * h;
            store_bf16x16(d, c0); store_bf16x16(d + 32, c1);
        } else if (cb == 3584) {
            if (h == 0) {
                float* d = (float*)(ws + R_DT) + (size_t)row * 8;
#pragma unroll
                for (int i = 0; i < 8; ++i) { const float x = c0[i] + dt_bias[i]; d[i] = (x > 20.f) ? x : log1pf(expf(x)); }
            }
        }
    };
    constexpr int NT = 15;
    { int mi, ni, hf; for (int rd = 0; tile_map(rd, NT, mi, ni, hf); ++rd) GEMM_DISPATCH((const u16*)(ws + OFF_XB), 1024, (const u16*)(ws + W_IN1), 1024, 1024, mi, ni * 256, hf, epi); }
}

DI void convT8(const u16* src, bool hist, float w0, float w1, float w2, float w3, float bias, float (&y)[8]) {
    const u32x4 cur = *(const u32x4*)src;
    u32x2 pv; pv.x = 0u; pv.y = 0u;
    if (hist) pv = *(const u32x2*)(src - 4);
    float x[11];
    x[0] = bfhi(pv.x); x[1] = bflo(pv.y); x[2] = bfhi(pv.y);
    x[3] = bflo(cur.x); x[4] = bfhi(cur.x); x[5] = bflo(cur.y); x[6] = bfhi(cur.y); x[7] = bflo(cur.z); x[8] = bfhi(cur.z); x[9] = bflo(cur.w); x[10] = bfhi(cur.w);
#pragma unroll
    for (int j = 0; j < 8; ++j) y[j] = silu_f(bias + w0 * x[j] + w1 * x[j + 1] + w2 * x[j + 2] + w3 * x[j + 3]);
}
DI void convT4(const u16* src, bool hist, float w0, float w1, float w2, float w3, float bias, float (&y)[4]) {
    const u32x2 cur = *(const u32x2*)src;
    u32x2 pv; pv.x = 0u; pv.y = 0u;
    if (hist) pv = *(const u32x2*)(src - 4);
    float x[7];
    x[0] = bfhi(pv.x); x[1] = bflo(pv.y); x[2] = bfhi(pv.y);
    x[3] = bflo(cur.x); x[4] = bfhi(cur.x); x[5] = bflo(cur.y); x[6] = bfhi(cur.y);
#pragma unroll
    for (int j = 0; j < 4; ++j) y[j] = silu_f(bias + w0 * x[j] + w1 * x[j + 1] + w2 * x[j + 2] + w3 * x[j + 3]);
}
DI bf16x8 convN8(const u16* src, int ld, int nh, const float* cw, const float* cb) {
    u32x4 x3 = *(const u32x4*)src, x2, x1, x0;
    x2.x = x2.y = x2.z = x2.w = 0u; x1 = x2; x0 = x2;
    if (nh >= 1) x2 = *(const u32x4*)(src - ld);
    if (nh >= 2) x1 = *(const u32x4*)(src - 2 * ld);
    if (nh >= 3) x0 = *(const u32x4*)(src - 3 * ld);
    float y[8];
#pragma unroll
    for (int q = 0; q < 2; ++q) {
        const f32x4 b = *(const f32x4*)(cb + 4 * q);
        const f32x4 t0 = *(const f32x4*)(cw + 4 * q), t1 = *(const f32x4*)(cw + 1024 + 4 * q), t2 = *(const f32x4*)(cw + 2048 + 4 * q), t3 = *(const f32x4*)(cw + 3072 + 4 * q);
        const unsigned a0 = q ? x0.z : x0.x, a0b = q ? x0.w : x0.y;
        const unsigned a1 = q ? x1.z : x1.x, a1b = q ? x1.w : x1.y;
        const unsigned a2 = q ? x2.z : x2.x, a2b = q ? x2.w : x2.y;
        const unsigned a3 = q ? x3.z : x3.x, a3b = q ? x3.w : x3.y;
        y[4 * q + 0] = silu_f(b.x + t0.x * bflo(a0) + t1.x * bflo(a1) + t2.x * bflo(a2) + t3.x * bflo(a3));
        y[4 * q + 1] = silu_f(b.y + t0.y * bfhi(a0) + t1.y * bfhi(a1) + t2.y * bfhi(a2) + t3.y * bfhi(a3));
        y[4 * q + 2] = silu_f(b.z + t0.z * bflo(a0b) + t1.z * bflo(a1b) + t2.z * bflo(a2b) + t3.z * bflo(a3b));
        y[4 * q + 3] = silu_f(b.w + t0.w * bfhi(a0b) + t1.w * bfhi(a1b) + t2.w * bfhi(a2b) + t3.w * bfhi(a3b));
    }
    return pack8(y[0], y[1], y[2], y[3], y[4], y[5], y[6], y[7]);
}

DI void ssd_tables(const Params& p, int b, int c, int g, float* tab, int tid) {
    const int hh = tid >> 6, lane = tid & 63;
    const int head = g * 4 + hh;
    const float A = -expf(p.in[19][head]);
    const float* dt = (const float*)(p.ws + R_DT) + ((size_t)b * S_ + c * 128) * 8 + head;
    const float d0 = dt[(2 * lane) * 8], d1 = dt[(2 * lane + 1) * 8];
    const float a0 = d0 * A, a1 = d1 * A;
    float incl = a0 + a1;
#pragma unroll
    for (int off = 1; off < 64; off <<= 1) { const float v = __shfl_up(incl, off, 64); if (lane >= off) incl += v; }
    tab[hh * 128 + 2 * lane] = d0; tab[hh * 128 + 2 * lane + 1] = d1;
    tab[512 + hh * 128 + 2 * lane] = incl - a1; tab[512 + hh * 128 + 2 * lane + 1] = incl;
}

DI void ssd_states_item(const Params& p, int it, char* lds, const int dry) {
    unsigned char* ws = p.ws;
    int tid = threadIdx.x;
    asm volatile("" : "+v"(tid));
    const int b = it >> 6, c = (it >> 1) & 31, g = it & 1;
    const int hh = (tid >> 6) & 3, nhalf = tid >> 8, lane = tid & 63, r = lane & 31, h = lane >> 5;
    float* tab = (float*)lds;
    __syncthreads();
    if (tid < 256) ssd_tables(p, b, c, g, tab, tid);
    __syncthreads();
    const int head = g * 4 + hh;
    const float alast = tab[512 + hh * 128 + 127];
    const float* cw = p.in[16];
    const float* cbias = p.in[17];
    bf16x8 af[2][8];
#pragma unroll
    for (int pt = 0; pt < 2; ++pt) {
        const int ch = g * 256 + hh * 64 + pt * 32 + r;
        const float w0 = cw[ch], w1 = cw[1024 + ch], w2 = cw[2048 + ch], w3 = cw[3072 + ch], bs = cbias[ch];
        const u16* src = (const u16*)(ws + R_XTRAW) + ((size_t)b * 512 + ch) * S_ + c * 128;
#pragma unroll
        for (int ks = 0; ks < 8; ++ks) {
            const int l0 = 16 * ks + 8 * h;
            float y[8];
            convT8(src + l0, (c * 128 + l0) > 0, w0, w1, w2, w3, bs, y);
#pragma unroll
            for (int j = 0; j < 8; ++j) y[j] *= tab[hh * 128 + l0 + j] * __expf(alast - tab[512 + hh * 128 + l0 + j]);
            af[pt][ks] = pack8(y[0], y[1], y[2], y[3], y[4], y[5], y[6], y[7]);
        }
    }
    u16* sst = (u16*)(ws + A_SST) + ((((size_t)b * 32 + c) * 8 + head) * 64) * 128;
#pragma unroll 1
    for (int nt2 = 0; nt2 < 2; ++nt2) {
        const int nt = 2 * nhalf + nt2;
        const int n = nt * 32 + r;
        const int chB = 512 + g * 128 + n;
        const float w0 = cw[chB], w1 = cw[1024 + chB], w2 = cw[2048 + chB], w3 = cw[3072 + chB], bs = cbias[chB];
        const u16* src = (const u16*)(ws + A_BTRAW) + ((size_t)b * 256 + g * 128 + n) * S_ + c * 128;
        f32x16 acc0 = zero16(), acc1 = zero16();
#pragma unroll
        for (int ks = 0; ks < 8; ++ks) {
            const int l0 = 16 * ks + 8 * h;
            float y[8];
            convT8(src + l0, (c * 128 + l0) > 0, w0, w1, w2, w3, bs, y);
            const bf16x8 bf = pack8(y[0], y[1], y[2], y[3], y[4], y[5], y[6], y[7]);
            acc0 = MFMA32(af[0][ks], bf, acc0);
            acc1 = MFMA32(af[1][ks], bf, acc1);
        }
#pragma unroll
        for (int i = 0; i < 16; ++i) {
            if (!dry) { sst[(size_t)(crow(i, h)) * 128 + n] = f2bf(acc0[i]);
            sst[(size_t)(32 + crow(i, h)) * 128 + n] = f2bf(acc1[i]); }
        }
    }
    if (lane == 0 && nhalf == 0 && !dry) ((float*)(ws + R_SDEC))[((size_t)b * 32 + c) * 8 + head] = __expf(alast);
}

DI void hg_states_item(const Params& p, int pair, char* lds, const int dry) {
    unsigned char* ws = p.ws;
    int tid = threadIdx.x;
    asm volatile("" : "+v"(tid));
    const int it = 2 * pair + (tid >> 8);
    lds += (tid >> 8) * 73728;
    tid &= 255;
    const int b = it >> 8, hd = (it >> 6) & 3, c = it & 63;
    const int w = tid >> 6, lane = tid & 63, r = lane & 31, h = lane >> 5;
    const int k = 32 * w + r, chan = hd * 128 + k;
    const size_t tbase = ((size_t)b * 512 + chan) * S_ + c * 64;
    const float* lf = (const float*)(ws + R_LFT) + tbase;
    const u16* hq = (const u16*)(ws + R_HQT) + tbase;
    const u16* hk = (const u16*)(ws + R_HKT) + tbase;
    float gc[4][8];
    float carry = 0.f;
#pragma unroll
    for (int ks = 0; ks < 4; ++ks) {
        const int l0 = 16 * ks + 8 * h;
        const f32x4 v0 = *(const f32x4*)(lf + l0), v1 = *(const f32x4*)(lf + l0 + 4);
        gc[ks][0] = v0.x; gc[ks][1] = gc[ks][0] + v0.y; gc[ks][2] = gc[ks][1] + v0.z; gc[ks][3] = gc[ks][2] + v0.w;
        gc[ks][4] = gc[ks][3] + v1.x; gc[ks][5] = gc[ks][4] + v1.y; gc[ks][6] = gc[ks][5] + v1.z; gc[ks][7] = gc[ks][6] + v1.w;
        const float tot = gc[ks][7], oth = xor32(tot);
        const float off = carry + (h ? oth : 0.f);
#pragma unroll
        for (int j = 0; j < 8; ++j) gc[ks][j] += off;
        carry += tot + oth;
    }
    const float glast = carry;
    bf16x8 bfr[4];
    u16* qs = ((u16*)p.out) + ((size_t)b * S_ + c * 64) * 512 + chan;
    u16* ksn = ((u16*)p.out + (size_t)T_ * 512) + ((size_t)b * S_ + c * 64) * 512 + chan;
#pragma unroll
    for (int ks = 0; ks < 4; ++ks) {
        const int l0 = 16 * ks + 8 * h;
        const u32x4 q8 = *(const u32x4*)(hq + l0), k8 = *(const u32x4*)(hk + l0);
        float qv[8], kv[8], kh[8];
        qv[0] = bflo(q8.x); qv[1] = bfhi(q8.x); qv[2] = bflo(q8.y); qv[3] = bfhi(q8.y); qv[4] = bflo(q8.z); qv[5] = bfhi(q8.z); qv[6] = bflo(q8.w); qv[7] = bfhi(q8.w);
        kv[0] = bflo(k8.x); kv[1] = bfhi(k8.x); kv[2] = bflo(k8.y); kv[3] = bfhi(k8.y); kv[4] = bflo(k8.z); kv[5] = bfhi(k8.z); kv[6] = bflo(k8.w); kv[7] = bfhi(k8.w);
#pragma unroll
        for (int j = 0; j < 8; ++j) {
            const float g = gc[ks][j];
            if (!dry) { qs[(size_t)(l0 + j) * 512] = f2bf(qv[j] * __expf(g));
            ksn[(size_t)(l0 + j) * 512] = f2bf(kv[j] * __expf(-g)); }
            kh[j] = kv[j] * __expf(glast - g);
        }
        bfr[ks] = pack8(kh[0], kh[1], kh[2], kh[3], kh[4], kh[5], kh[6], kh[7]);
    }
    if (h == 0 && !dry) ((float*)(ws + R_HDEC))[(((size_t)b * 4 + hd) * 64 + c) * 128 + k] = __expf(glast);
    u16* hs = (u16*)(ws + R_HS) + ((((size_t)b * 4 + hd) * 64 + c) * 128) * 128 + k;
    const u16* vt = (const u16*)(ws + R_HVT) + ((size_t)b * 512 + hd * 128 + r) * S_ + c * 64 + 8 * h;
    bf16x8 avf[4][4];
#pragma unroll
    for (int v4 = 0; v4 < 4; ++v4)
#pragma unroll
        for (int ks = 0; ks < 4; ++ks) avf[v4][ks] = *(const bf16x8*)(vt + (size_t)(v4 * 32) * S_ + 16 * ks);
#pragma unroll
    for (int v4 = 0; v4 < 4; ++v4) {
        f32x16 acc = zero16();
#pragma unroll
        for (int ks = 0; ks < 4; ++ks) acc = MFMA32(avf[v4][ks], bfr[ks], acc);
#pragma unroll
        for (int i = 0; i < 16; ++i) if (!dry) hs[(size_t)(v4 * 32 + crow(i, h)) * 128] = f2bf(acc[i]);
    }
}

DI void phase_states(const Params& p, char* lds, const int dry) {
    for (int it = blockIdx.x; it < 256 + 512; it += gridDim.x) {
        if (it < 256) ssd_states_item(p, it, lds, dry);
        else hg_states_item(p, it - 256, lds, dry);
    }
}

DI void phase_scan(const Params& p, char* lds, const int dry) {
    unsigned char* ws = p.ws;
    const int gtid = blockIdx.x * NTHR + threadIdx.x, gsz = gridDim.x * NTHR;
    for (int id = gtid; id < 131072; id += gsz) {
        if (id < 65536) {
            const int n4 = id & 31, pp = (id >> 5) & 63, head = (id >> 11) & 7, b = id >> 14;
            u16* base = (u16*)(ws + A_SST) + (((size_t)b * 32 * 8 + head) * 64 + pp) * 128 + 4 * n4;
            const float* dec = (const float*)(ws + R_SDEC) + (size_t)b * 32 * 8 + head;
            float h0 = 0.f, h1 = 0.f, h2 = 0.f, h3 = 0.f;
            for (int c0 = 0; c0 < 32; c0 += 16) {
                u32x2 sv[16]; float dv[16];
#pragma unroll
                for (int u = 0; u < 16; ++u) { sv[u] = *(const u32x2*)(base + (size_t)(c0 + u) * 8 * 64 * 128); dv[u] = dec[(c0 + u) * 8]; }
#pragma unroll
                for (int u = 0; u < 16; ++u) {
                    u32x2 o; o.x = pk2(h0, h1); o.y = pk2(h2, h3);
                    if (!dry) *(u32x2*)(base + (size_t)(c0 + u) * 8 * 64 * 128) = o;
                    h0 = dv[u] * h0 + bflo(sv[u].x); h1 = dv[u] * h1 + bfhi(sv[u].x); h2 = dv[u] * h2 + bflo(sv[u].y); h3 = dv[u] * h3 + bfhi(sv[u].y);
                }
            }
        } else {
            const int j = id - 65536;
            const int k4 = j & 31, v = (j >> 5) & 127, hd = (j >> 12) & 3, b = j >> 14;
            u16* base = (u16*)(ws + R_HS) + ((((size_t)b * 4 + hd) * 64) * 128 + v) * 128 + 4 * k4;
            const float* dec = (const float*)(ws + R_HDEC) + (((size_t)b * 4 + hd) * 64) * 128 + 4 * k4;
            float h0 = 0.f, h1 = 0.f, h2 = 0.f, h3 = 0.f;
            for (int c0 = 0; c0 < 64; c0 += 16) {
                u32x2 sv[16]; f32x4 dv[16];
#pragma unroll
                for (int u = 0; u < 16; ++u) { sv[u] = *(const u32x2*)(base + (size_t)(c0 + u) * 128 * 128); dv[u] = *(const f32x4*)(dec + (size_t)(c0 + u) * 128); }
#pragma unroll
                for (int u = 0; u < 16; ++u) {
                    u32x2 o; o.x = pk2(h0, h1); o.y = pk2(h2, h3);
                    if (!dry) *(u32x2*)(base + (size_t)(c0 + u) * 128 * 128) = o;
                    h0 = dv[u].x * h0 + bflo(sv[u].x); h1 = dv[u].y * h1 + bfhi(sv[u].x); h2 = dv[u].z * h2 + bflo(sv[u].y); h3 = dv[u].w * h3 + bfhi(sv[u].y);
                }
            }
        }
    }
    convert_jobs(p, 8, 10, lds, dry);
}

DI void ssd_out_item(const Params& p, int it, char* lds, const int dry) {
    unsigned char* ws = p.ws;
    int tid = threadIdx.x;
    asm volatile("" : "+v"(tid));
    const int b = it >> 6, c = (it >> 1) & 31, g = it & 1;
    const int w = (tid >> 6) & 3, hsel = tid >> 8, lane = tid & 63, r = lane & 31, h = lane >> 5;
    float* tab = (float*)lds;
    __syncthreads();
    if (tid < 256) ssd_tables(p, b, c, g, tab, tid);
    const float* cw = p.in[16];
    const float* cbias = p.in[17];
    const int l = 32 * w + r;
    const size_t t = (size_t)b * S_ + c * 128 + l;
    const u16* bc = (const u16*)(ws + R_BCRAW);
    constexpr int BCROW = 272;
    char* Bs = lds + 4096;
    char* Cs = Bs + 128 * BCROW;
    char* Xs = Cs + 128 * BCROW;
    {
        const int cc = tid & 15;
#pragma unroll
        for (int i = 0; i < 4; ++i) {
            const int ll = (tid >> 4) + 32 * i;
            const size_t tt = (size_t)b * S_ + c * 128 + ll;
            const int nh = min(3, c * 128 + ll);
            *(bf16x8*)(Bs + ll * BCROW + cc * 16) = convN8(bc + tt * 512 + g * 128 + 8 * cc, 512, nh, cw + 512 + g * 128 + 8 * cc, cbias + 512 + g * 128 + 8 * cc);
            *(bf16x8*)(Cs + ll * BCROW + cc * 16) = convN8(bc + tt * 512 + 256 + g * 128 + 8 * cc, 512, nh, cw + 768 + g * 128 + 8 * cc, cbias + 768 + g * 128 + 8 * cc);
        }
    }
    {
        const int sc = tid & 15;
#pragma unroll 4
        for (int i = 0; i < 8; ++i) {
            const int chl = (tid >> 4) + 32 * i;
            const int ch = g * 256 + chl;
            const float w0 = cw[ch], w1 = cw[1024 + ch], w2 = cw[2048 + ch], w3 = cw[3072 + ch], bs = cbias[ch];
            const u16* src = (const u16*)(ws + R_XTRAW) + ((size_t)b * 512 + ch) * S_ + c * 128 + 8 * sc;
            float y[8];
            convT8(src, (c * 128 + 8 * sc) > 0, w0, w1, w2, w3, bs, y);
            *(bf16x8*)(Xs + chl * BCROW + sc * 16) = pack8(y[0], y[1], y[2], y[3], y[4], y[5], y[6], y[7]);
        }
    }
    __syncthreads();
    unsigned Xp[4][8];
    {
        bf16x8 cf[8];
#pragma unroll
        for (int ks = 0; ks < 8; ++ks) cf[ks] = *(const bf16x8*)(Cs + l * BCROW + ks * 32 + h * 16);
#pragma unroll
        for (int st = 0; st < 4; ++st) {
            f32x16 X = zero16();
            if (st <= w) {
#pragma unroll
                for (int ks = 0; ks < 8; ++ks) {
                    const bf16x8 bfr = *(const bf16x8*)(Bs + (32 * st + r) * BCROW + ks * 32 + h * 16);
                    X = MFMA32(bfr, cf[ks], X);
                }
            }
#pragma unroll
            for (int i = 0; i < 8; ++i) Xp[st][i] = pk2(X[2 * i], X[2 * i + 1]);
        }
    }
    const u16* zs = (const u16*)(ws + R_ZS) + t * 512 + g * 256;
    u16* dst = (u16*)(ws + R_MIX1) + t * 1024 + g * 256;
    float ss = 0.f;
#pragma unroll 1
    for (int hq = 0; hq < 2; ++hq) {
        const int hh = 2 * hsel + hq;
        const int head = g * 4 + hh;
        f32x16 acc0 = zero16(), acc1 = zero16();
        {
            const u16* prev = (const u16*)(ws + A_SST) + ((((size_t)b * 32 + c) * 8 + head) * 64 + r) * 128 + 8 * h;
            int opq = 0;
            asm volatile("" : "+v"(opq));
            const char* Cl = Cs + l * BCROW + h * 16 + opq;
            bf16x8 pf0[8], pf1[8];
#pragma unroll
            for (int ks = 0; ks < 8; ++ks) { pf0[ks] = *(const bf16x8*)(prev + 16 * ks); pf1[ks] = *(const bf16x8*)(prev + (size_t)32 * 128 + 16 * ks); }
            __builtin_amdgcn_sched_barrier(0);
#pragma unroll
            for (int ks = 0; ks < 8; ++ks) {
                const bf16x8 cfk = *(const bf16x8*)(Cl + ks * 32);
                acc0 = MFMA32(pf0[ks], cfk, acc0);
                acc1 = MFMA32(pf1[ks], cfk, acc1);
            }
            const float el = __expf(tab[512 + hh * 128 + l]);
            scale16(acc0, el); scale16(acc1, el);
        }
        const float al = tab[512 + hh * 128 + l];
        const float Dh = p.in[20][head];
        const char* x0 = Xs + (hh * 64 + r) * BCROW + 8 * h;
        const float* tdt = tab + hh * 128 + 4 * h;
        const float* tac = tab + 512 + hh * 128 + 4 * h;
#pragma unroll
        for (int st = 0; st < 4; ++st) {
            if (st <= w) {
                float mm[16];
#pragma unroll
                for (int i = 0; i < 16; ++i) {
                    const int so = 32 * st + (i & 3) + 8 * (i >> 2);
                    float m = ((i & 1) ? bfhi(Xp[st][i >> 1]) : bflo(Xp[st][i >> 1])) * tdt[so] * __expf(al - tac[so]);
                    const int s = so + 4 * h;
                    if (s > l) m = 0.f;
                    if (s == l) m += Dh;
                    mm[i] = m;
                }
                const bf16x8 p0 = pack8(mm[0], mm[1], mm[2], mm[3], mm[4], mm[5], mm[6], mm[7]);
                const bf16x8 p1 = pack8(mm[8], mm[9], mm[10], mm[11], mm[12], mm[13], mm[14], mm[15]);
#pragma unroll
                for (int sub = 0; sub < 2; ++sub) {
                    const int so = (32 * st + 16 * sub) * 2;
                    const u32x2 a0 = *(const u32x2*)(x0 + so), a1 = *(const u32x2*)(x0 + so + 16);
                    const u32x2 b0 = *(const u32x2*)(x0 + 32 * BCROW + so), b1 = *(const u32x2*)(x0 + 32 * BCROW + so + 16);
                    u32x4 va, vb; va.x = a0.x; va.y = a0.y; va.z = a1.x; va.w = a1.y; vb.x = b0.x; vb.y = b0.y; vb.z = b1.x; vb.w = b1.y;
                    acc0 = MFMA32(__builtin_bit_cast(bf16x8, va), sub ? p1 : p0, acc0);
                    acc1 = MFMA32(__builtin_bit_cast(bf16x8, vb), sub ? p1 : p0, acc1);
                }
            }
        }
#pragma unroll
        for (int pt = 0; pt < 2; ++pt)
#pragma unroll
            for (int q = 0; q < 4; ++q) {
                const int cc = hh * 64 + pt * 32 + 8 * q + 4 * h;
                const u32x2 z = *(const u32x2*)(zs + cc);
                const float y0 = (pt ? acc1[4 * q] : acc0[4 * q]) * bflo(z.x), y1 = (pt ? acc1[4 * q + 1] : acc0[4 * q + 1]) * bfhi(z.x);
                const float y2 = (pt ? acc1[4 * q + 2] : acc0[4 * q + 2]) * bflo(z.y), y3 = (pt ? acc1[4 * q + 3] : acc0[4 * q + 3]) * bfhi(z.y);
                ss += y0 * y0 + y1 * y1 + y2 * y2 + y3 * y3;
                u32x2 o; o.x = pk2(y0, y1); o.y = pk2(y2, y3);
                if (!dry) *(u32x2*)(dst + cc) = o;
            }
    }
    ss += xor32(ss);
    __syncthreads();
    if (h == 0) ((float*)Bs)[(hsel * 4 + w) * 32 + r] = ss;
    __syncthreads();
    ss += ((const float*)Bs)[((hsel ^ 1) * 4 + w) * 32 + r];
    const float rs = rsqrtf(ss * (1.f / 256.f) + EPS);
    const float* nw = p.in[21] + g * 256;
#pragma unroll 1
    for (int hq = 0; hq < 2; ++hq)
#pragma unroll
        for (int pq = 0; pq < 8; ++pq) {
            const int cc = (2 * hsel + hq) * 64 + (pq >> 2) * 32 + 8 * (pq & 3) + 4 * h;
            const f32x4 wv = *(const f32x4*)(nw + cc);
            const u32x2 y = *(const u32x2*)(dst + cc);
            u32x2 o; o.x = pk2(bflo(y.x) * rs * wv.x, bfhi(y.x) * rs * wv.y); o.y = pk2(bflo(y.y) * rs * wv.z, bfhi(y.y) * rs * wv.w);
            if (!dry) *(u32x2*)(dst + cc) = o;
        }
}

DI void hg_out_item(const Params& p, int pair, char* lds, const int dry) {
    unsigned char* ws = p.ws;
    int tid = threadIdx.x;
    asm volatile("" : "+v"(tid));
    const int it = 2 * pair + (tid >> 8);
    lds += (tid >> 8) * 73728;
    tid &= 255;
    const int b = it >> 8, hd = (it >> 6) & 3, c = it & 63;
    const int w = tid >> 6, lane = tid & 63, r = lane & 31, h = lane >> 5;
    const int lt = w & 1, vh = w >> 1;
    const int l = 32 * lt + r;
    const size_t t0 = (size_t)b * S_ + c * 64;
    const size_t t = t0 + l;
    bf16x8 qf[8];
    {
        const u16* qs = ((const u16*)p.out) + t * 512 + hd * 128 + 8 * h;
#pragma unroll
        for (int ks = 0; ks < 8; ++ks) qf[ks] = *(const bf16x8*)(qs + 16 * ks);
    }
    f32x16 acc[2];
    {
        const u16* prev = (const u16*)(ws + R_HS) + ((((size_t)b * 4 + hd) * 64 + c) * 128 + vh * 64 + r) * 128 + 8 * h;
        bf16x8 pf[2][8];
#pragma unroll
        for (int v2 = 0; v2 < 2; ++v2)
#pragma unroll
            for (int ks = 0; ks < 8; ++ks) pf[v2][ks] = *(const bf16x8*)(prev + (size_t)(v2 * 32) * 128 + 16 * ks);
        __builtin_amdgcn_sched_barrier(0);
        acc[0] = zero16(); acc[1] = zero16();
#pragma unroll
        for (int ks = 0; ks < 8; ++ks) { acc[0] = MFMA32(pf[0][ks], qf[ks], acc[0]); acc[1] = MFMA32(pf[1][ks], qf[ks], acc[1]); }
    }
    for (int st = 0; st <= lt; ++st) {
        f32x16 X = zero16();
        u32x2 vlo[2][2], vhi[2][2];
        {
            const u16* kk = ((const u16*)p.out + (size_t)T_ * 512) + (t0 + 32 * st + r) * 512 + hd * 128 + 8 * h;
            bf16x8 kf[8];
#pragma unroll
            for (int ks = 0; ks < 8; ++ks) kf[ks] = *(const bf16x8*)(kk + 16 * ks);
#pragma unroll
            for (int v2 = 0; v2 < 2; ++v2) {
                const u16* vt = (const u16*)(ws + R_HVT) + ((size_t)b * 512 + hd * 128 + vh * 64 + v2 * 32 + r) * S_ + c * 64 + 32 * st + 4 * h;
#pragma unroll
                for (int sub = 0; sub < 2; ++sub) { vlo[v2][sub] = *(const u32x2*)(vt + 16 * sub); vhi[v2][sub] = *(const u32x2*)(vt + 16 * sub + 8); }
            }
            __builtin_amdgcn_sched_barrier(0);
#pragma unroll
            for (int ks = 0; ks < 8; ++ks) X = MFMA32(kf[ks], qf[ks], X);
        }
        float mm[16];
#pragma unroll
        for (int i = 0; i < 16; ++i) { const int s = 32 * st + crow(i, h); mm[i] = (s > l) ? 0.f : X[i]; }
        const bf16x8 p0 = pack8(mm[0], mm[1], mm[2], mm[3], mm[4], mm[5], mm[6], mm[7]);
        const bf16x8 p1 = pack8(mm[8], mm[9], mm[10], mm[11], mm[12], mm[13], mm[14], mm[15]);
#pragma unroll
        for (int v2 = 0; v2 < 2; ++v2) {
#pragma unroll
            for (int sub = 0; sub < 2; ++sub) {
                u32x4 vv; vv.x = vlo[v2][sub].x; vv.y = vlo[v2][sub].y; vv.z = vhi[v2][sub].x; vv.w = vhi[v2][sub].y;
                acc[v2] = MFMA32(__builtin_bit_cast(bf16x8, vv), sub ? p1 : p0, acc[v2]);
            }
        }
    }
    float ss = sumsq16(acc[0]) + sumsq16(acc[1]);
    ss += xor32(ss);
    float* xch = (float*)lds;
    __syncthreads();
    if (h == 0) xch[w * 32 + r] = ss;
    __syncthreads();
    ss += xch[(w ^ 2) * 32 + r];
    const float rs = rsqrtf(ss * (1.f / 128.f) + EPS);
    const float* gn = p.in[22];
    const u16* hg = (const u16*)(ws + R_HG) + t * 512 + hd * 128;
    u16* dst = (u16*)(ws + R_MIX1) + t * 1024 + 512 + hd * 128;
#pragma unroll
    for (int v2 = 0; v2 < 2; ++v2)
#pragma unroll
        for (int q = 0; q < 4; ++q) {
            const int vv = vh * 64 + v2 * 32 + 8 * q + 4 * h;
            const f32x4 wv = *(const f32x4*)(gn + vv);
            const u32x2 gg = *(const u32x2*)(hg + vv);
            u32x2 o;
            o.x = pk2(acc[v2][4 * q] * rs * wv.x * bflo(gg.x), acc[v2][4 * q + 1] * rs * wv.y * bfhi(gg.x));
            o.y = pk2(acc[v2][4 * q + 2] * rs * wv.z * bflo(gg.y), acc[v2][4 * q + 3] * rs * wv.w * bfhi(gg.y));
            if (!dry) *(u32x2*)(dst + vv) = o;
        }
}

DI void phase_outputs(const Params& p, char* lds, const int dry) {
    for (int it = blockIdx.x; it < 256 + 512; it += gridDim.x) {
        if (it < 256) ssd_out_item(p, it, lds, dry);
        else hg_out_item(p, it - 256, lds, dry);
    }
}

DI void phase_final(const Params& p) {
    const int tid = threadIdx.x, lane = tid & 63;
    const int gw = (blockIdx.x * NTHR + tid) >> 6, nw = (gridDim.x * NTHR) >> 6;
    const float* ssq = (const float*)(p.ws + SSQP_R) + (size_t)3 * T_ * 16;
    const float* wn = p.in[3];
    const u16* xb = (const u16*)(p.ws + OFF_XB);
    for (int row0 = gw * 2; row0 < T_; row0 += nw * 2) {
        u32x4 v[2][2];
#pragma unroll
        for (int rr = 0; rr < 2; ++rr)
#pragma unroll
            for (int jj = 0; jj < 2; ++jj) v[rr][jj] = *(const u32x4*)(xb + (size_t)(row0 + rr) * 1024 + jj * 512 + lane * 8);
#pragma unroll
        for (int rr = 0; rr < 2; ++rr) {
            const float rs = rsqrtf(ssq_get16(ssq + (size_t)(row0 + rr) * 16) * (1.f / 1024.f) + EPS);
#pragma unroll
            for (int jj = 0; jj < 2; ++jj) {
                const f32x4 w0 = *(const f32x4*)(wn + jj * 512 + lane * 8), w1 = *(const f32x4*)(wn + jj * 512 + lane * 8 + 4);
                const u32x4 q = v[rr][jj];
                f32x4 o0, o1;
                o0.x = bflo(q.x) * rs * w0.x; o0.y = bfhi(q.x) * rs * w0.y; o0.z = bflo(q.y) * rs * w0.z; o0.w = bfhi(q.y) * rs * w0.w;
                o1.x = bflo(q.z) * rs * w1.x; o1.y = bfhi(q.z) * rs * w1.y; o1.z = bflo(q.w) * rs * w1.z; o1.w = bfhi(q.w) * rs * w1.w;
                float* dst = p.out + (size_t)(row0 + rr) * 1024 + jj * 512 + lane * 8;
                *(f32x4*)dst = o0; *(f32x4*)(dst + 4) = o1;
            }
        }
    }
}

#ifndef PROBE
#define PROBE 0
#endif
constexpr int LDS_BYTES = GEMM_LDS;
#define RUN_PHASE(k, call_dry, call) do { if (PROBE == (k)) { int dry = 1; asm volatile("" : "+s"(dry)); call_dry; xcd_barrier(xb); } { constexpr int dry = 0; call; } } while (0)
__global__ void __launch_bounds__(NTHR, 2) fwd_kernel(Params p) {
    extern __shared__ __attribute__((aligned(16))) char lds[];
    __shared__ uint4 xb_words;
    if (threadIdx.x == 0) xb_words = make_uint4(0u, 0u, 0u, 0u);
    __syncthreads();
    int* s_item_p = (int*)&xb_words + 2;
    cg::grid_group grid = cg::this_grid();
    unsigned char* ws = p.ws;
    float* ssqr = (float*)(ws + SSQP_R);
    if (p.ws == nullptr) grid.sync();
    const XcdBarrier xb = xcd_barrier_post((unsigned*)(ws + OFF_BAR), (volatile LAS unsigned*)&xb_words);
    { constexpr int dry = 0; phase0(p, lds, dry); }
    if (PROBE == 1) { xcd_barrier(xb); int dry = 1; asm volatile("" : "+s"(dry)); phase0(p, lds, dry); }
    xcd_barrier(xb);
    RUN_PHASE(2, phase_inproj0(p, lds, dry), phase_inproj0(p, lds, dry));
    xcd_barrier(xb);
    RUN_PHASE(3, phase_upproj0(p, lds, dry), phase_upproj0(p, lds, dry));
    xcd_barrier(xb);
    RUN_PHASE(4, phase_attn(p, lds, s_item_p, dry), phase_attn(p, lds, s_item_p, dry));
    xcd_barrier(xb);
    RUN_PHASE(5, phase_resid(p, lds, (const u16*)(ws + R_MIX0), 1024, (const u16*)(ws + W_OUT0), ssqr, dry),
              phase_resid(p, lds, (const u16*)(ws + R_MIX0), 1024, (const u16*)(ws + W_OUT0), ssqr, dry));
    xcd_barrier(xb);
    RUN_PHASE(6, phase_ffn_up(p, lds, (const u16*)(ws + W_GU0), ssqr, dry), phase_ffn_up(p, lds, (const u16*)(ws + W_GU0), ssqr, dry));
    xcd_barrier(xb);
    RUN_PHASE(7, phase_resid(p, lds, (const u16*)(ws + R_H), 2816, (const u16*)(ws + W_D0), ssqr + (size_t)1 * T_ * 16, dry),
              phase_resid(p, lds, (const u16*)(ws + R_H), 2816, (const u16*)(ws + W_D0), ssqr + (size_t)1 * T_ * 16, dry));
    xcd_barrier(xb);
    RUN_PHASE(8, phase_inproj1(p, lds, dry), phase_inproj1(p, lds, dry));
    xcd_barrier(xb);
    RUN_PHASE(9, phase_states(p, lds, dry), phase_states(p, lds, dry));
    xcd_barrier(xb);
    RUN_PHASE(10, phase_scan(p, lds, dry), phase_scan(p, lds, dry));
    xcd_barrier(xb);
    RUN_PHASE(11, phase_outputs(p, lds, dry), phase_outputs(p, lds, dry));
    xcd_barrier(xb);
    { constexpr int dry = 0; phase_resid(p, lds, (const u16*)(ws + R_MIX1), 1024, (const u16*)(ws + W_OUT1), ssqr + (size_t)2 * T_ * 16, dry); }
    xcd_barrier(xb);
    { constexpr int dry = 0; phase_ffn_up(p, lds, (const u16*)(ws + W_GU1), ssqr + (size_t)2 * T_ * 16, dry); }
    xcd_barrier(xb);
    { constexpr int dry = 0; phase_resid(p, lds, (const u16*)(ws + R_H), 2816, (const u16*)(ws + W_D1), ssqr + (size_t)3 * T_ * 16, dry); }
    xcd_barrier(xb);
    phase_final(p);
    if (PROBE == 12) { for (int i = 0; i < 10; ++i) xcd_barrier(xb); }
}

extern "C" void kernel_launch(void* const* d_in, const int* in_sizes, int n_in, void* d_out, int out_size, void* d_ws, size_t ws_size, hipStream_t stream) {
    static int grid_blocks = 0;
    if (grid_blocks == 0) {
        if (n_in != 28 || out_size != T_ * 1024 || ws_size < WS_END2) {
            fprintf(stderr, "kernel_launch: unexpected problem (n_in %d, out %d, ws %zu need %zu)\n", n_in, out_size, ws_size, (size_t)WS_END2);
            grid_blocks = -1; return;
        }
        int dev = 0, cus = 0, per_cu = 0;
        hipGetDevice(&dev);
        hipDeviceGetAttribute(&cus, hipDeviceAttributeMultiprocessorCount, dev);
        hipFuncSetAttribute((const void*)fwd_kernel, hipFuncAttributeMaxDynamicSharedMemorySize, LDS_BYTES);
        hipOccupancyMaxActiveBlocksPerMultiprocessor(&per_cu, (const void*)fwd_kernel, NTHR, LDS_BYTES);
        if (per_cu < 1) { fprintf(stderr, "kernel_launch: occupancy query says %d blocks per CU\n", per_cu); per_cu = 1; }
        if (per_cu > 1) per_cu = 1;
        grid_blocks = (cus * per_cu) & ~7;
        fprintf(stderr, "kernel_launch: %d CUs x %d blocks\n", cus, per_cu);
    }
    if (grid_blocks < 0) return;
    if (hipMemsetAsync((char*)d_ws + OFF_CTRL, 0, OFF_SSQ, stream) != hipSuccess) { fprintf(stderr, "kernel_launch: memset of the control words failed\n"); return; }
    Params p{};
    for (int i = 0; i < 28; ++i) p.in[i] = (const float*)d_in[i];
    p.out = (float*)d_out;
    p.ws = (unsigned char*)d_ws;
    void* args[] = {&p};
    hipError_t e = hipLaunchCooperativeKernel((const void*)fwd_kernel, dim3(grid_blocks), dim3(NTHR), args, LDS_BYTES, stream);
    if (e != hipSuccess) fprintf(stderr, "cooperative launch failed: %s (grid %d)\n", hipGetErrorString(e), grid_blocks);
}
```
